# Optimizing an MI355X kernel written in HIP

```python
import jax, jax.numpy as jnp
from jax import lax
import numpy as np

D_MODEL = 1024
BATCH = 4
SEQ = 8192
DEPTH = 4

Q_BLOCK = 128
SB_HEADS = 8
SB_HEAD_DIM = 64
MLA_HEADS = 8
MLA_NOPE_DIM = 64
MLA_ROPE_DIM = 32
MLA_V_DIM = 64
MLA_Q_RANK = 768
MLA_KV_RANK = 256
ROPE_THETA = 10000.0
CONV_WIDTH = D_MODEL
CONV_K = 3
D_FF = 2816
LN_EPS = 1e-5
RMS_EPS = 1e-6
DEEPNORM_ALPHA = (2 * DEPTH) ** 0.25
DEEPNORM_BETA = (8 * DEPTH) ** -0.25
N_EVEN = (DEPTH + 1) // 2
N_ODD = DEPTH // 2
SB_WIDTH = SB_HEADS * SB_HEAD_DIM
MLA_WIDTH = MLA_HEADS * MLA_V_DIM
MIX_IN_SPLITS = (SB_WIDTH, 2 * SB_WIDTH, 3 * SB_WIDTH,
                 3 * SB_WIDTH + MLA_Q_RANK, 3 * SB_WIDTH + MLA_Q_RANK + MLA_KV_RANK)
MIX_IN_WIDTH = 3 * SB_WIDTH + MLA_Q_RANK + MLA_KV_RANK + MLA_ROPE_DIM

kernel_name = "hybrid_stickbreak_mla_shortconv_macaron"


def layer_norm(x, g, b):
    xf = x.astype(jnp.float32)
    mu = jnp.mean(xf, -1, keepdims=True)
    var = jnp.mean(jnp.square(xf - mu), -1, keepdims=True)
    y = (xf - mu) * lax.rsqrt(var + LN_EPS) * g.astype(jnp.float32) + b.astype(jnp.float32)
    return y.astype(x.dtype)


def rms_norm(x, g):
    xf = x.astype(jnp.float32)
    y = xf * lax.rsqrt(jnp.mean(xf * xf, -1, keepdims=True) + RMS_EPS) * g.astype(jnp.float32)
    return y.astype(x.dtype)


def swiglu(x, w_gate, w_up, w_down):
    return (jax.nn.silu(x @ w_gate) * (x @ w_up)) @ w_down


def rope_tables(seq, dtype):
    inv_freq = ROPE_THETA ** (-jnp.arange(0, MLA_ROPE_DIM, 2, dtype=jnp.float32) / MLA_ROPE_DIM)
    ang = jnp.arange(seq, dtype=jnp.float32)[:, None] * inv_freq[None, :]
    return jnp.cos(ang).astype(dtype), jnp.sin(ang).astype(dtype)


def apply_rope(x, cos, sin):
    half = x.shape[-1] // 2
    x1, x2 = x[..., :half], x[..., half:]
    return jnp.concatenate([x1 * cos - x2 * sin, x2 * cos + x1 * sin], axis=-1)


def to_blocks(t):
    b, s = t.shape[:2]
    return t.reshape(b, s // Q_BLOCK, Q_BLOCK, *t.shape[2:]).swapaxes(0, 1)


def from_blocks(t):
    nb, b, qb = t.shape[:3]
    return t.swapaxes(0, 1).reshape(b, nb * qb, *t.shape[3:])


def stick_breaking_attention(q, k, v):
    seq, d = q.shape[1], q.shape[-1]
    scale = d ** -0.5
    key_pos = jnp.arange(seq)

    def one_block(args):
        qb, blk = args
        q_pos = blk * Q_BLOCK + jnp.arange(Q_BLOCK)
        z = jnp.einsum('bqhd,bkhd->bhqk', qb, k, preferred_element_type=jnp.float32) * scale
        past = key_pos[None, :] < q_pos[:, None]
        log_beta = jax.nn.log_sigmoid(z)
        log_not = jnp.where(past, log_beta - z, 0.0)
        later = lax.cumsum(log_not, axis=3, reverse=True) - log_not
        w = jnp.where(past, jnp.exp(log_beta + later), 0.0)
        return jnp.einsum('bhqk,bkhd->bqhd', w.astype(v.dtype), v)

    out = lax.map(one_block, (to_blocks(q), jnp.arange(seq // Q_BLOCK)))
    return from_blocks(out)


def mla_attention(q_nope, q_rope, k_nope, k_rope, v):
    seq = q_nope.shape[1]
    scale = (MLA_NOPE_DIM + MLA_ROPE_DIM) ** -0.5
    key_pos = jnp.arange(seq)

    def one_block(args):
        qn, qr, blk = args
        q_pos = blk * Q_BLOCK + jnp.arange(Q_BLOCK)
        s = (jnp.einsum('bqhd,bkhd->bhqk', qn, k_nope, preferred_element_type=jnp.float32)
             + jnp.einsum('bqhr,bkr->bhqk', qr, k_rope, preferred_element_type=jnp.float32)) * scale
        s = jnp.where(key_pos[None, :] <= q_pos[:, None], s, -jnp.inf)
        p = jax.nn.softmax(s, axis=-1)
        return jnp.einsum('bhqk,bkhd->bqhd', p.astype(v.dtype), v)

    out = lax.map(one_block, (to_blocks(q_nope), to_blocks(q_rope), jnp.arange(seq // Q_BLOCK)))
    return from_blocks(out)


def attention_group_mixer(x, w_in, q_norm_g, w_uq, kv_norm_g, w_ukv, w_out, cos, sin):
    b, s, _ = x.shape
    q_sb, k_sb, v_sb, c_q, c_kv, k_rope = jnp.split(x @ w_in, MIX_IN_SPLITS, axis=-1)
    sb_shape = (b, s, SB_HEADS, SB_HEAD_DIM)
    out_sb = stick_breaking_attention(q_sb.reshape(sb_shape), k_sb.reshape(sb_shape),
                                      v_sb.reshape(sb_shape)).reshape(b, s, SB_WIDTH)
    q = (rms_norm(c_q, q_norm_g) @ w_uq).reshape(b, s, MLA_HEADS, MLA_NOPE_DIM + MLA_ROPE_DIM)
    q_nope = q[..., :MLA_NOPE_DIM]
    q_rope = apply_rope(q[..., MLA_NOPE_DIM:], cos[:, None, :], sin[:, None, :])
    kv = (rms_norm(c_kv, kv_norm_g) @ w_ukv).reshape(b, s, MLA_HEADS, MLA_NOPE_DIM + MLA_V_DIM)
    k_nope, v = kv[..., :MLA_NOPE_DIM], kv[..., MLA_NOPE_DIM:]
    k_rope = apply_rope(k_rope, cos, sin)
    out_mla = mla_attention(q_nope, q_rope, k_nope, k_rope, v).reshape(b, s, MLA_WIDTH)
    return jnp.concatenate([out_sb, out_mla], axis=-1) @ w_out


def short_conv_mixer(x, w_in, conv_w, w_out):
    gate_b, gate_c, h = jnp.split(x @ w_in, 3, axis=-1)
    u = gate_c * h
    conv = lax.conv_general_dilated(
        u, conv_w[:, None, :], window_strides=(1,), padding=[(CONV_K - 1, 0)],
        dimension_numbers=('NWC', 'WIO', 'NWC'), feature_group_count=CONV_WIDTH)
    return (gate_b * conv) @ w_out


def _dense(key, shape, fan_in, scale=1.0):
    return jax.random.normal(key, shape, jnp.float32) * (scale * fan_in ** -0.5)


def setup_inputs(seed: int = 0) -> dict:
    key = jax.random.key(seed)
    ks = jax.random.split(key, 16)
    n = lambda k, shape: jax.random.normal(k, shape, jnp.float32)
    mix_out_in = SB_WIDTH + MLA_WIDTH
    return {
        "x": n(ks[0], (BATCH, SEQ, D_MODEL)),
        "ln_g": 1.0 + 0.02 * n(ks[1], (DEPTH, 3, D_MODEL)),
        "ln_b": 0.02 * n(ks[2], (DEPTH, 3, D_MODEL)),
        "ffn_w_gate": _dense(ks[3], (DEPTH, 2, D_MODEL, D_FF), D_MODEL),
        "ffn_w_up": _dense(ks[4], (DEPTH, 2, D_MODEL, D_FF), D_MODEL),
        "ffn_w_down": _dense(ks[5], (DEPTH, 2, D_FF, D_MODEL), D_FF, DEEPNORM_BETA),
        "mix_w_in": _dense(ks[6], (N_EVEN, D_MODEL, MIX_IN_WIDTH), D_MODEL),
        "mla_q_norm_g": 1.0 + 0.02 * n(ks[7], (N_EVEN, MLA_Q_RANK)),
        "mla_w_uq": _dense(ks[8], (N_EVEN, MLA_Q_RANK, MLA_HEADS * (MLA_NOPE_DIM + MLA_ROPE_DIM)), MLA_Q_RANK),
        "mla_kv_norm_g": 1.0 + 0.02 * n(ks[9], (N_EVEN, MLA_KV_RANK)),
        "mla_w_ukv": _dense(ks[10], (N_EVEN, MLA_KV_RANK, MLA_HEADS * (MLA_NOPE_DIM + MLA_V_DIM)), MLA_KV_RANK),
        "mix_w_out": _dense(ks[11], (N_EVEN, mix_out_in, D_MODEL), mix_out_in, DEEPNORM_BETA),
        "conv_w_in": _dense(ks[12], (N_ODD, D_MODEL, 3 * CONV_WIDTH), D_MODEL),
        "conv_w": _dense(ks[13], (N_ODD, CONV_K, CONV_WIDTH), CONV_K),
        "conv_w_out": _dense(ks[14], (N_ODD, CONV_WIDTH, D_MODEL), CONV_WIDTH, DEEPNORM_BETA),
    }


def reference(x, ln_g, ln_b, ffn_w_gate, ffn_w_up, ffn_w_down, mix_w_in, mla_q_norm_g, mla_w_uq,
              mla_kv_norm_g, mla_w_ukv, mix_w_out, conv_w_in, conv_w, conv_w_out):
    cos, sin = rope_tables(x.shape[1], x.dtype)
    for layer in range(DEPTH):
        j = layer // 2
        f1 = swiglu(x, ffn_w_gate[layer, 0], ffn_w_up[layer, 0], ffn_w_down[layer, 0])
        x = layer_norm(DEEPNORM_ALPHA * x + 0.5 * f1, ln_g[layer, 0], ln_b[layer, 0])
        if layer % 2 == 0:
            m = attention_group_mixer(x, mix_w_in[j], mla_q_norm_g[j], mla_w_uq[j], mla_kv_norm_g[j],
                                      mla_w_ukv[j], mix_w_out[j], cos, sin)
        else:
            m = short_conv_mixer(x, conv_w_in[j], conv_w[j], conv_w_out[j])
        x = layer_norm(DEEPNORM_ALPHA * x + m, ln_g[layer, 1], ln_b[layer, 1])
        f2 = swiglu(x, ffn_w_gate[layer, 1], ffn_w_up[layer, 1], ffn_w_down[layer, 1])
        x = layer_norm(DEEPNORM_ALPHA * x + 0.5 * f2, ln_g[layer, 2], ln_b[layer, 2])
    return x
```

```cpp
#include <hip/hip_runtime.h>
#include <hip/hip_cooperative_groups.h>
#include <cstdio>
#include <cstdint>
#include <cmath>
namespace cg = cooperative_groups;
namespace pg8 {
#define PG8_LAS __attribute__((address_space(3)))
typedef unsigned short bf16_t;
typedef short bf16x8 __attribute__((ext_vector_type(8)));
typedef float f32x4 __attribute__((ext_vector_type(4)));
typedef unsigned u32x4 __attribute__((ext_vector_type(4)));
constexpr int BM = 256, BK = 64, HALF = 128, HTB = HALF * BK * 2  , STAGE_BYTES = 8 * HTB, NXCD = 8, WGM = 8;

__host__ __device__ __forceinline__ int lds_byte(int r, int c) { const int st = (r >> 4) * 2 + (c >> 5), rr = r & 15, cc = c & 31, ob = rr * 64 + cc * 2; return st * 1024 + (ob ^ (((ob >> 9) & 1) << 5)); }
__host__ __device__ __forceinline__ void stage_rc(int b, int& R, int& C) { const int st = b / 1024, sb = b % 1024, swz = sb ^ (((sb >> 9) & 1) << 5); R = (st >> 1) * 16 + swz / 64; C = (st & 1) * 32 + (swz % 64) / 2; }
__host__ __device__ __forceinline__ int perm32(int rho) { const int n = rho >> 4, i = rho & 15; return 8 * (i >> 2) + 4 * n + (i & 3); }

struct Unit { int pm, pn; };
struct Gemm { const bf16_t* A; const bf16_t* Bt; int M, N, K; };

struct StaticOrder {
    int nM, nN, nwg, G, c;
    __host__ __device__ void init(int M, int N, int G_, int c_) { nM = M / BM; nN = N / BM; nwg = nM * nN; G = G_; c = c_; }
    __host__ __device__ bool next(int i, Unit& u) const {
        const long L = (long)i * G + c; if (L >= nwg) return false;
        int wgid = (int)L; { const int q = nwg / NXCD, r = nwg % NXCD, xcd = wgid % NXCD, off = wgid / NXCD; wgid = (xcd < r ? xcd * (q + 1) : r * (q + 1) + (xcd - r) * q) + off; }
        const int nig = WGM * nN, gid = wgid / nig, fm = gid * WGM, gsz = (nM - fm) < WGM ? (nM - fm) : WGM;
        u.pm = fm + ((wgid % nig) % gsz); u.pn = (wgid % nig) / gsz; return true;
    }
    __device__ __forceinline__ void a_ready(const Unit&) const {}
    __device__ __forceinline__ void done(const Unit&) const {}
};

__device__ __forceinline__ unsigned cvt_pk_bf16(float lo, float hi) { unsigned r; asm volatile("v_cvt_pk_bf16_f32 %0, %1, %2" : "=v"(r) : "v"(lo), "v"(hi)); return r; }
typedef unsigned u32x2 __attribute__((ext_vector_type(2)));
__device__ __forceinline__ u32x4 pack8(const f32x4 v0, const f32x4 v1) { u32x4 w; w.x = cvt_pk_bf16(v0[0], v0[1]); w.y = cvt_pk_bf16(v0[2], v0[3]); w.z = cvt_pk_bf16(v1[0], v1[1]); w.w = cvt_pk_bf16(v1[2], v1[3]); return w; }
__device__ __forceinline__ f32x4 shfl32(const f32x4 v) { f32x4 p; p[0] = __shfl_xor(v[0], 32); p[1] = __shfl_xor(v[1], 32); p[2] = __shfl_xor(v[2], 32); p[3] = __shfl_xor(v[3], 32); return p; }
__device__ __forceinline__ f32x4 rope4(const f32x4 v, const float* cosT, const float* sinT, int pos, int fq, int n) {
    const f32x4 p = shfl32(v); const int i0 = (8 * fq + 4 * n) & 15;
    const f32x4 c = *(const f32x4*)(cosT + pos * 16 + i0), s = *(const f32x4*)(sinT + pos * 16 + i0);
    return fq < 2 ? v * c - p * s : v * c + p * s;
}
struct EpiSwiGLU { static constexpr bool PERM = true, AFTER_DRAIN = false; bf16_t* O; int ldc;
    __device__ __forceinline__ void operator()(const f32x4 (&acc)[2][2][4][2], const Unit& u, int wr, int wc, int fr, int fq) const {
        const int row0 = u.pm * BM + wr * 64 + fr, col0 = u.pn * HALF + wc * 32 + 8 * fq;
#pragma unroll
        for (int ai = 0; ai < 2; ++ai)
#pragma unroll
            for (int m = 0; m < 4; ++m) { bf16_t* rowp = O + (size_t)(row0 + ai * HALF + m * 16) * ldc + col0; f32x4 h[2];
#pragma unroll
                for (int n = 0; n < 2; ++n) { const f32x4 g = acc[ai][0][m][n], up = acc[ai][1][m][n];
#pragma unroll
                    for (int e = 0; e < 4; ++e) h[n][e] = g[e] * __builtin_amdgcn_rcpf(1.0f + __builtin_amdgcn_exp2f(-1.4426950408889634f * g[e])) * up[e]; }
                *(u32x4*)rowp = pack8(h[0], h[1]); }
    }
};
struct EpiResid { static constexpr bool PERM = false, AFTER_DRAIN = false; const float* base; float* out; float alpha, s;
    __device__ __forceinline__ void operator()(const f32x4 (&acc)[2][2][4][2], const Unit& u, int wr, int wc, int fr, int fq) const {
        const int row0 = u.pm * BM + wr * 64 + fr, col0 = u.pn * BM + wc * 32 + 4 * fq;
#pragma unroll
        for (int ai = 0; ai < 2; ++ai)
#pragma unroll
            for (int m = 0; m < 4; ++m) { const size_t off = (size_t)(row0 + ai * HALF + m * 16) * 1024 + col0;
#pragma unroll
                for (int bj = 0; bj < 2; ++bj)
#pragma unroll
                    for (int n = 0; n < 2; ++n) { const size_t p = off + bj * HALF + n * 16; const f32x4 bs = *(const f32x4*)(base + p); *(f32x4*)(out + p) = bs * alpha + acc[ai][bj][m][n] * s; }
                asm volatile("" ::: "memory"); }
    }
};
struct EpiMixIn { static constexpr bool PERM = true, AFTER_DRAIN = false;
    bf16_t *sb, *cq, *ckv, *kr; float *ssq_q, *ssq_kv; const float *cosT, *sinT; float qscale;
    __device__ __forceinline__ void operator()(const f32x4 (&acc)[2][2][4][2], const Unit& u, int wr, int wc, int fr, int fq) const {
        const int pn = u.pn, row0 = u.pm * BM + wr * 64 + fr;
        if (pn <= 9) {
            bf16_t* base; int ldc, colt; float sc = 1.f; float* ssq = nullptr;
            if (pn < 6) { base = sb; ldc = 1536; colt = pn * 256; if (pn < 2) sc = qscale; }
            else if (pn < 9) { base = cq; ldc = 768; colt = (pn - 6) * 256; ssq = ssq_q; }
            else { base = ckv; ldc = 256; colt = 0; ssq = ssq_kv; }
            const int col0 = colt + wc * 32 + 8 * fq;
#pragma unroll
            for (int ai = 0; ai < 2; ++ai)
#pragma unroll
                for (int m = 0; m < 4; ++m) { const int r = row0 + ai * HALF + m * 16; bf16_t* rowp = base + (size_t)r * ldc + col0; float ss = 0.f;
#pragma unroll
                    for (int bj = 0; bj < 2; ++bj) { const f32x4 v0 = acc[ai][bj][m][0] * sc, v1 = acc[ai][bj][m][1] * sc;
                        ss += (v0[0] * v0[0] + v0[1] * v0[1]) + (v0[2] * v0[2] + v0[3] * v0[3]) + (v1[0] * v1[0] + v1[1] * v1[1]) + (v1[2] * v1[2] + v1[3] * v1[3]);
                        *(u32x4*)(rowp + bj * HALF) = pack8(v0, v1); }
                    if (ssq) { ss += __shfl_xor(ss, 16); ss += __shfl_xor(ss, 32); if (fq == 0) atomicAdd(ssq + r, ss); } }
        } else if (wc == 0) {
#pragma unroll
            for (int ai = 0; ai < 2; ++ai)
#pragma unroll
                for (int m = 0; m < 4; ++m) { const int r = row0 + ai * HALF + m * 16, pos = r & 8191;
                    const f32x4 v0 = rope4(acc[ai][0][m][0], cosT, sinT, pos, fq, 0), v1 = rope4(acc[ai][0][m][1], cosT, sinT, pos, fq, 1);
                    *(u32x4*)(kr + (size_t)r * 32 + 8 * fq) = pack8(v0, v1); }
        }
    }
};
struct EpiQ { static constexpr bool PERM = true, AFTER_DRAIN = false; bf16_t* Q; const float* ssq; const float *cosT, *sinT; float c2;
    __device__ __forceinline__ void operator()(const f32x4 (&acc)[2][2][4][2], const Unit& u, int wr, int wc, int fr, int fq) const {
        const int row0 = u.pm * BM + wr * 64 + fr, col0 = u.pn * BM + wc * 32 + 8 * fq;
#pragma unroll
        for (int ai = 0; ai < 2; ++ai)
#pragma unroll
            for (int m = 0; m < 4; ++m) { const int r = row0 + ai * HALF + m * 16, pos = r & 8191; const float rs = c2 / sqrtf(ssq[r] * (1.0f / 768.0f) + 1e-6f);
#pragma unroll
                for (int bj = 0; bj < 2; ++bj) { const int G = 8 * u.pn + 4 * bj + wc; f32x4 v0 = acc[ai][bj][m][0] * rs, v1 = acc[ai][bj][m][1] * rs;
                    if (G % 3 == 2) { v0 = rope4(v0, cosT, sinT, pos, fq, 0); v1 = rope4(v1, cosT, sinT, pos, fq, 1); }
                    *(u32x4*)(Q + (size_t)r * 768 + col0 + bj * HALF) = pack8(v0, v1); } }
    }
};
struct EpiKV { static constexpr bool PERM = true, AFTER_DRAIN = false; bf16_t* KV; const float* ssq;
    __device__ __forceinline__ void operator()(const f32x4 (&acc)[2][2][4][2], const Unit& u, int wr, int wc, int fr, int fq) const {
        const int row0 = u.pm * BM + wr * 64 + fr, col0 = u.pn * BM + wc * 32 + 8 * fq;
#pragma unroll
        for (int ai = 0; ai < 2; ++ai)
#pragma unroll
            for (int m = 0; m < 4; ++m) { const int r = row0 + ai * HALF + m * 16; const float rs = 1.0f / sqrtf(ssq[r] * (1.0f / 256.0f) + 1e-6f);
#pragma unroll
                for (int bj = 0; bj < 2; ++bj) *(u32x4*)(KV + (size_t)r * 1024 + col0 + bj * HALF) = pack8(acc[ai][bj][m][0] * rs, acc[ai][bj][m][1] * rs); }
    }
};
struct EpiConvIn { static constexpr bool PERM = true, AFTER_DRAIN = false; bf16_t *U, *GB;
    __device__ __forceinline__ void operator()(const f32x4 (&acc)[2][2][4][2], const Unit& u, int wr, int wc, int fr, int fq) const {
        const int row0 = u.pm * BM + wr * 64 + fr, pn = u.pn;
#pragma unroll
        for (int ai = 0; ai < 2; ++ai)
#pragma unroll
            for (int m = 0; m < 4; ++m) { const size_t r = (size_t)(row0 + ai * HALF + m * 16);
                if (pn < 8) *(u32x4*)(U + r * 1024 + pn * HALF + wc * 32 + 8 * fq) = pack8(acc[ai][0][m][0] * acc[ai][1][m][0], acc[ai][0][m][1] * acc[ai][1][m][1]);
                else {
#pragma unroll
                    for (int bj = 0; bj < 2; ++bj) *(u32x4*)(GB + r * 1024 + (pn - 8) * BM + bj * HALF + wc * 32 + 8 * fq) = pack8(acc[ai][bj][m][0], acc[ai][bj][m][1]); } }
    }
};
template <class Epi, class Sched, bool ALIGN_EPI = false, bool SP2 = false>
__device__ __forceinline__ void gemm_phase(PG8_LAS unsigned char* lds, const Gemm g, const Sched& S, const Epi& E) {
    int tid_l = threadIdx.x; asm volatile("" : "+v"(tid_l)); const int tid = tid_l, wid = __builtin_amdgcn_readfirstlane(tid >> 6), lane = tid & 63, wr = wid >> 2, wc = wid & 3, fr = lane & 15, fq = lane >> 4;
    const int K = g.K, nt = K / BK;
    unsigned voffA[2], voffB[2];
#pragma unroll
    for (int i = 0; i < 2; ++i) { int R, C; stage_rc(tid * 16 + i * 8192, R, C); const int Rb = Epi::PERM ? ((R & ~31) + perm32(R & 31)) : R;
        voffA[i] = (unsigned)(R * K + C) * 2u; voffB[i] = (unsigned)(Rb * K + C) * 2u; }
    const size_t kstep = (size_t)(BK * 2);
    const size_t hstep = (size_t)HALF * K * 2;
    const size_t tstep = 2 * hstep;
    const unsigned ldsw = (unsigned)wid * 1024u;
    const int aoff = lds_byte(wr * 64 + fr, fq * 8), boff = lds_byte(wc * 32 + fr, fq * 8);
#define PG8_SA(b, h) (((b) * 2 + (h)) * HTB)
#define PG8_SB(b, h) ((4 + (b) * 2 + (h)) * HTB)
#define PG8_STAGE(bufoff, gbase, voff) do { _Pragma("unroll") for (int _i = 0; _i < 2; ++_i) \
        __builtin_amdgcn_global_load_lds((const unsigned*)((const char*)(gbase) + (voff)[_i]), (PG8_LAS unsigned*)(lds + (bufoff) + ldsw + _i * 8192), 16, 0, 0); } while (0)
#define PG8_LDA(dst, b, h) do { _Pragma("unroll") for (int m = 0; m < 4; ++m) _Pragma("unroll") for (int k = 0; k < 2; ++k) dst[m][k] = *(const PG8_LAS bf16x8*)(lds + PG8_SA(b, h) + aoff + m * 2048 + k * 1024); } while (0)
#define PG8_LDB(dst, b, h) do { _Pragma("unroll") for (int n = 0; n < 2; ++n) _Pragma("unroll") for (int k = 0; k < 2; ++k) dst[n][k] = *(const PG8_LAS bf16x8*)(lds + PG8_SB(b, h) + boff + n * 2048 + k * 1024); } while (0)
#define PG8_MMA(ai, bj, At, Bt) do { __builtin_amdgcn_s_setprio(1); _Pragma("unroll") for (int m = 0; m < 4; ++m) _Pragma("unroll") for (int n = 0; n < 2; ++n) _Pragma("unroll") for (int k = 0; k < 2; ++k) \
        acc[ai][bj][m][n] = __builtin_amdgcn_mfma_f32_16x16x32_bf16(Bt[n][k], At[m][k], acc[ai][bj][m][n], 0, 0, 0); __builtin_amdgcn_s_setprio(0); } while (0)
#define PG8_WAIT_V(n) asm volatile("s_waitcnt vmcnt(" #n ")" ::: "memory")
#define PG8_WAIT_L(n) asm volatile("s_waitcnt lgkmcnt(" #n ")" ::: "memory")
#define PG8_BAR __builtin_amdgcn_s_barrier()
#define PG8_SCHED __builtin_amdgcn_sched_barrier(0)
    Unit cur, nxt; int ui = 0;
    if (!S.next(0, cur)) return;
    f32x4 acc[2][2][4][2];
#pragma unroll
    for (int a = 0; a < 2; ++a)
#pragma unroll
        for (int b = 0; b < 2; ++b)
#pragma unroll
            for (int m = 0; m < 4; ++m)
#pragma unroll
                for (int n = 0; n < 2; ++n) acc[a][b][m][n] = (f32x4){0.f, 0.f, 0.f, 0.f};
    bf16x8 At[4][2], B0[2][2], B1[2][2];
    const char* cA = (const char*)g.A + (size_t)cur.pm * tstep; const char* cB = (const char*)g.Bt + (size_t)cur.pn * tstep;
    S.a_ready(cur);
    if constexpr (SP2) {
        PG8_STAGE(PG8_SB(0, 0), cB, voffB); PG8_STAGE(PG8_SB(0, 1), cB + hstep, voffB); PG8_STAGE(PG8_SA(0, 0), cA, voffA); PG8_STAGE(PG8_SA(0, 1), cA + hstep, voffA);
        if (wr == 1) PG8_BAR;
        PG8_WAIT_V(2); PG8_BAR;
        PG8_STAGE(PG8_SB(1, 0), cB + kstep, voffB); PG8_STAGE(PG8_SA(1, 0), cA + kstep, voffA); PG8_STAGE(PG8_SB(1, 1), cB + hstep + kstep, voffB);
        PG8_WAIT_V(6); PG8_BAR;
    } else {
        PG8_STAGE(PG8_SB(0, 0), cB, voffB); PG8_STAGE(PG8_SA(0, 0), cA, voffA); PG8_STAGE(PG8_SB(0, 1), cB + hstep, voffB); PG8_STAGE(PG8_SA(0, 1), cA + hstep, voffA);
        if (wr == 1) PG8_BAR;
        PG8_WAIT_V(4); PG8_BAR;
        PG8_STAGE(PG8_SB(1, 0), cB + kstep, voffB); PG8_STAGE(PG8_SA(1, 0), cA + kstep, voffA); PG8_STAGE(PG8_SB(1, 1), cB + hstep + kstep, voffB);
        PG8_WAIT_V(6); PG8_BAR;
    }
    for (;;) {
        const bool has_next = S.next(ui + 1, nxt);
        const char* nA = has_next ? (const char*)g.A + (size_t)nxt.pm * tstep : cA; const char* nB = has_next ? (const char*)g.Bt + (size_t)nxt.pn * tstep : cB;
        for (int t = 0; t < nt; t += 2) {
            const bool last = (t == nt - 2);
            const char* a1 = cA + (size_t)(t + 1) * kstep;
            const char* a2 = last ? nA : cA + (size_t)(t + 2) * kstep; const char* b2 = last ? nB : cB + (size_t)(t + 2) * kstep;
            const char* a3 = a2 + kstep; const char* b3 = b2 + kstep;
            if (last && has_next) S.a_ready(nxt);
            if constexpr (SP2) {
            PG8_LDB(B0, 0, 0); PG8_LDB(B1, 0, 1); PG8_SCHED; PG8_LDA(At, 0, 0); PG8_STAGE(PG8_SA(1, 1), a1 + hstep, voffA);
            PG8_WAIT_V(8); PG8_WAIT_L(0); PG8_BAR; PG8_MMA(0, 0, At, B0); PG8_MMA(0, 1, At, B1); PG8_BAR; PG8_SCHED;
            PG8_LDA(At, 0, 1); PG8_STAGE(PG8_SB(0, 0), b2, voffB); PG8_STAGE(PG8_SB(0, 1), b2 + hstep, voffB); PG8_STAGE(PG8_SA(0, 0), a2, voffA);
            PG8_WAIT_V(8); PG8_WAIT_L(0); PG8_BAR; PG8_MMA(1, 0, At, B0); PG8_MMA(1, 1, At, B1); PG8_BAR; PG8_SCHED;
            PG8_LDB(B0, 1, 0); PG8_LDB(B1, 1, 1); PG8_SCHED; PG8_LDA(At, 1, 0); PG8_STAGE(PG8_SA(0, 1), a2 + hstep, voffA);
            PG8_WAIT_V(8); PG8_WAIT_L(0); PG8_BAR; PG8_MMA(0, 0, At, B0); PG8_MMA(0, 1, At, B1); PG8_BAR; PG8_SCHED;
            PG8_LDA(At, 1, 1); PG8_STAGE(PG8_SB(1, 0), b3, voffB); PG8_STAGE(PG8_SB(1, 1), b3 + hstep, voffB); PG8_STAGE(PG8_SA(1, 0), a3, voffA);
            PG8_WAIT_V(8); PG8_WAIT_L(0); PG8_BAR; PG8_MMA(1, 0, At, B0); PG8_MMA(1, 1, At, B1); PG8_BAR; PG8_SCHED;
            } else {
            PG8_LDB(B0, 0, 0); PG8_SCHED; PG8_LDA(At, 0, 0); PG8_STAGE(PG8_SA(1, 1), a1 + hstep, voffA);
            PG8_WAIT_L(8); PG8_BAR; PG8_WAIT_L(0); PG8_MMA(0, 0, At, B0); PG8_BAR; PG8_SCHED;
            PG8_LDB(B1, 0, 1); PG8_STAGE(PG8_SB(0, 0), b2, voffB);
            PG8_BAR; PG8_WAIT_L(0); PG8_MMA(0, 1, At, B1); PG8_BAR;
            PG8_LDA(At, 0, 1); PG8_STAGE(PG8_SA(0, 0), a2, voffA);
            PG8_BAR; PG8_WAIT_L(0); PG8_MMA(1, 0, At, B0); PG8_BAR; PG8_SCHED;
            PG8_STAGE(PG8_SB(0, 1), b2 + hstep, voffB);
            PG8_WAIT_V(6); PG8_BAR; PG8_MMA(1, 1, At, B1); PG8_BAR;
            PG8_LDB(B0, 1, 0); PG8_SCHED; PG8_LDA(At, 1, 0); PG8_STAGE(PG8_SA(0, 1), a2 + hstep, voffA);
            PG8_WAIT_L(8); PG8_BAR; PG8_WAIT_L(0); PG8_MMA(0, 0, At, B0); PG8_BAR; PG8_SCHED;
            PG8_LDB(B1, 1, 1); PG8_STAGE(PG8_SB(1, 0), b3, voffB);
            PG8_BAR; PG8_WAIT_L(0); PG8_MMA(0, 1, At, B1); PG8_BAR;
            PG8_LDA(At, 1, 1); PG8_STAGE(PG8_SA(1, 0), a3, voffA);
            PG8_BAR; PG8_WAIT_L(0); PG8_MMA(1, 0, At, B0); PG8_BAR; PG8_SCHED;
            PG8_STAGE(PG8_SB(1, 1), b3 + hstep, voffB);
            PG8_WAIT_V(6); PG8_BAR; PG8_MMA(1, 1, At, B1); PG8_BAR;
            }
        }
        if constexpr (ALIGN_EPI) { if (wr == 0) PG8_BAR; }
        if constexpr (!Epi::AFTER_DRAIN) { E(acc, cur, wr, wc, fr, fq); S.done(cur); }
        if (!has_next) break;
#pragma unroll
        for (int a = 0; a < 2; ++a)
#pragma unroll
            for (int b = 0; b < 2; ++b)
#pragma unroll
                for (int m = 0; m < 4; ++m)
#pragma unroll
                    for (int n = 0; n < 2; ++n) acc[a][b][m][n] = (f32x4){0.f, 0.f, 0.f, 0.f};
        cur = nxt; cA = nA; cB = nB; ++ui;
        if constexpr (ALIGN_EPI) { if (wr == 1) PG8_BAR; }
    }
    PG8_WAIT_V(0);
    if constexpr (!ALIGN_EPI) { if (wr == 0) PG8_BAR; }
    PG8_BAR;
    if constexpr (Epi::AFTER_DRAIN) { E.fused(acc, cur, wr, wc, fr, fq, lds, wid, lane); S.done(cur); }
#undef PG8_SA
#undef PG8_SB
#undef PG8_STAGE
#undef PG8_LDA
#undef PG8_LDB
#undef PG8_MMA
#undef PG8_WAIT_V
#undef PG8_WAIT_L
#undef PG8_BAR
#undef PG8_SCHED
}
}
#ifndef PG8_SP2
#define PG8_SP2 true
#endif
#ifndef PG8_ALIGN
#define PG8_ALIGN true
#endif
#define LAS __attribute__((address_space(3)))
typedef unsigned short bf16_t;
typedef short bf16x8 __attribute__((ext_vector_type(8)));
typedef short s16x4 __attribute__((ext_vector_type(4)));
typedef float f32x4 __attribute__((ext_vector_type(4)));
typedef float f32x16 __attribute__((ext_vector_type(16)));
typedef unsigned u32x4 __attribute__((ext_vector_type(4)));
typedef unsigned u32x2 __attribute__((ext_vector_type(2)));
typedef float f32x2_t __attribute__((ext_vector_type(2))); typedef __bf16 bf16x2_t __attribute__((ext_vector_type(2)));
__device__ __forceinline__ unsigned cvtpk(float lo, float hi) { f32x2_t v = {lo, hi}; bf16x2_t b = __builtin_convertvector(v, bf16x2_t); return __builtin_bit_cast(unsigned, b); }
__device__ __forceinline__ s16x4 vtr(const LAS unsigned char* p) { return __builtin_bit_cast(s16x4, __builtin_amdgcn_ds_read_tr16_b64_v4i16((LAS s16x4*)p)); }
__device__ __forceinline__ int crow(int r, int hi) { return (r & 3) + 8 * (r >> 2) + 4 * hi; }
__device__ __forceinline__ bf16x8 packp(const f32x16& p, int b) { u32x4 w; w.x = cvtpk(p[b], p[b + 1]); w.y = cvtpk(p[b + 2], p[b + 3]); w.z = cvtpk(p[b + 4], p[b + 5]); w.w = cvtpk(p[b + 6], p[b + 7]); return __builtin_bit_cast(bf16x8, w); }
__device__ __forceinline__ bf16x8 vfrag(const LAS unsigned char* vp) { const s16x4 lo = vtr(vp), hi = vtr(vp + 512); return (bf16x8){lo[0], lo[1], lo[2], lo[3], hi[0], hi[1], hi[2], hi[3]}; }

constexpr int SEQ = 8192;
constexpr int KP = 208;
constexpr int MLA_KB = 64 * KP, MLA_STAGE = MLA_KB + 8192;

__device__ __forceinline__ void mla_unit(int b, int h, int qb, const bf16_t* Q, const bf16_t* KV, const bf16_t* KR, bf16_t* O, LAS unsigned char* lds) {
    int tid_l = threadIdx.x; asm volatile("" : "+v"(tid_l)); const int tid = tid_l, lane = tid & 63, r = lane & 31, hi = lane >> 5, wid = __builtin_amdgcn_readfirstlane(tid >> 6);
    const size_t rowbase = (size_t)b * SEQ; const int q0 = qb * 256;
    bf16x8 qf[6];
    { const bf16_t* qp = Q + (rowbase + q0 + wid * 32 + r) * 768 + h * 96 + hi * 8;
#pragma unroll
      for (int ks = 0; ks < 6; ++ks) qf[ks] = *(const bf16x8*)(qp + ks * 16); }
    const int NT = 4 * qb + 4;
    const int lrow = tid >> 3, lch = tid & 7;
    const bf16_t* kvsrc = KV + (rowbase + lrow) * 1024 + h * 128 + lch * 8;
    const int kdst = lrow * KP + lch * 16;
    const int vdst = MLA_KB + (lch >> 2) * 4096 + (lrow >> 3) * 512 + (lrow & 7) * 64 + (lch & 3) * 16;
    const int rrow = (tid & 255) >> 2, rch = tid & 3;
    const bf16_t* krsrc = KR + (rowbase + rrow) * 32 + rch * 8;
    const int rdst = rrow * KP + 128 + rch * 16;
    u32x4 kreg, vreg, rreg = {0u, 0u, 0u, 0u};
#define MLA_LOADT(t) do { kreg = *(const u32x4*)(kvsrc + (size_t)(t) * 65536); vreg = *(const u32x4*)(kvsrc + (size_t)(t) * 65536 + 64); if (tid < 256) rreg = *(const u32x4*)(krsrc + (size_t)(t) * 2048); } while (0)
#define MLA_STORET(s) do { *(LAS u32x4*)(lds + (s) * MLA_STAGE + kdst) = kreg; *(LAS u32x4*)(lds + (s) * MLA_STAGE + vdst) = vreg; if (tid < 256) *(LAS u32x4*)(lds + (s) * MLA_STAGE + rdst) = rreg; } while (0)
    MLA_LOADT(0); MLA_STORET(0); __syncthreads();
    float mx = -INFINITY, l = 0.f; f32x16 o0 = {}, o1 = {};
    const int ka = r * KP + hi * 16;
    const int va = MLA_KB + ((lane >> 4) & 1) * 32 + (lane & 3) * 8 + (4 * hi + ((lane & 15) >> 2)) * 64;
    for (int t = 0; t < NT; ++t) {
        const int st = t & 1; const bool more = (t + 1 < NT);
        if (more) MLA_LOADT(t + 1);
        const int jb = t - (NT - 4);
        const bool active = (jb < 0) || (64 * jb <= wid * 32 + 31);
        if (active) {
            const LAS unsigned char* Ks = lds + st * MLA_STAGE;
            f32x16 p0 = {}, p1 = {};
#pragma unroll
            for (int ks = 0; ks < 6; ++ks) {
                const bf16x8 a0 = *(const LAS bf16x8*)(Ks + ka + ks * 32), a1 = *(const LAS bf16x8*)(Ks + ka + 32 * KP + ks * 32);
                p0 = __builtin_amdgcn_mfma_f32_32x32x16_bf16(a0, qf[ks], p0, 0, 0, 0);
                p1 = __builtin_amdgcn_mfma_f32_32x32x16_bf16(a1, qf[ks], p1, 0, 0, 0);
            }
            if (jb >= 0) { const int qrel = wid * 32 + r, kb = 64 * jb + 4 * hi;
#pragma unroll
                for (int i = 0; i < 16; ++i) { const int kv = kb + (i & 3) + 8 * (i >> 2); if (kv > qrel) p0[i] = -INFINITY; if (kv + 32 > qrel) p1[i] = -INFINITY; } }
            float rm = fmaxf(p0[0], p1[0]);
#pragma unroll
            for (int i = 1; i < 16; ++i) rm = fmaxf(rm, fmaxf(p0[i], p1[i]));
            rm = fmaxf(rm, __shfl_xor(rm, 32));
            const float mn = fmaxf(mx, rm), alpha = __builtin_amdgcn_exp2f(mx - mn); mx = mn;
            float sum = 0.f;
#pragma unroll
            for (int i = 0; i < 16; ++i) { p0[i] = __builtin_amdgcn_exp2f(p0[i] - mn); p1[i] = __builtin_amdgcn_exp2f(p1[i] - mn); sum += p0[i] + p1[i]; }
            l = l * alpha + sum;
#pragma unroll
            for (int i = 0; i < 16; ++i) { o0[i] *= alpha; o1[i] *= alpha; }
            const bf16x8 pw0 = packp(p0, 0), pw1 = packp(p0, 8), pw2 = packp(p1, 0), pw3 = packp(p1, 8);
            const LAS unsigned char* vp = Ks + va;
            o0 = __builtin_amdgcn_mfma_f32_32x32x16_bf16(vfrag(vp), pw0, o0, 0, 0, 0);
            o1 = __builtin_amdgcn_mfma_f32_32x32x16_bf16(vfrag(vp + 4096), pw0, o1, 0, 0, 0);
            o0 = __builtin_amdgcn_mfma_f32_32x32x16_bf16(vfrag(vp + 1024), pw1, o0, 0, 0, 0);
            o1 = __builtin_amdgcn_mfma_f32_32x32x16_bf16(vfrag(vp + 4096 + 1024), pw1, o1, 0, 0, 0);
            o0 = __builtin_amdgcn_mfma_f32_32x32x16_bf16(vfrag(vp + 2048), pw2, o0, 0, 0, 0);
            o1 = __builtin_amdgcn_mfma_f32_32x32x16_bf16(vfrag(vp + 4096 + 2048), pw2, o1, 0, 0, 0);
            o0 = __builtin_amdgcn_mfma_f32_32x32x16_bf16(vfrag(vp + 3072), pw3, o0, 0, 0, 0);
            o1 = __builtin_amdgcn_mfma_f32_32x32x16_bf16(vfrag(vp + 4096 + 3072), pw3, o1, 0, 0, 0);
        }
        if (more) MLA_STORET(st ^ 1);
        __syncthreads();
    }
#undef MLA_LOADT
#undef MLA_STORET
    l += __shfl_xor(l, 32);
    const float inv = 1.0f / l;
    bf16_t* op = O + (rowbase + q0 + wid * 32 + r) * 1024 + 512 + h * 64 + 4 * hi;
#pragma unroll
    for (int g = 0; g < 4; ++g) {
        u32x2 w0, w1; w0.x = cvtpk(o0[4 * g] * inv, o0[4 * g + 1] * inv); w0.y = cvtpk(o0[4 * g + 2] * inv, o0[4 * g + 3] * inv);
        w1.x = cvtpk(o1[4 * g] * inv, o1[4 * g + 1] * inv); w1.y = cvtpk(o1[4 * g + 2] * inv, o1[4 * g + 3] * inv);
        *(u32x2*)(op + 8 * g) = w0; *(u32x2*)(op + 32 + 8 * g) = w1;
    }
}

__device__ __forceinline__ void sb_half(f32x16& p, float& carry, int kvb, int hi, int tq, bool diag) {
    float ln[16];
#pragma unroll
    for (int i = 0; i < 16; ++i) { const float y = p[i]; const float sp = fmaxf(y, 0.f) + __builtin_amdgcn_logf(1.0f + __builtin_amdgcn_exp2f(-fabsf(y)));
        float a = -sp, lb = y - sp;
        if (diag) { const bool valid = (kvb + crow(i, hi)) < tq; a = valid ? a : 0.f; lb = valid ? lb : -INFINITY; }
        ln[i] = a; p[i] = lb; }
    float T[4], PT[4];
#pragma unroll
    for (int g = 0; g < 4; ++g) { T[g] = (ln[4 * g] + ln[4 * g + 1]) + (ln[4 * g + 2] + ln[4 * g + 3]); PT[g] = __shfl_xor(T[g], 32); }
    float own[4], pin[5];
    own[3] = 0.f; own[2] = T[3]; own[1] = own[2] + T[2]; own[0] = own[1] + T[1];
    pin[4] = 0.f; pin[3] = PT[3]; pin[2] = pin[3] + PT[2]; pin[1] = pin[2] + PT[1]; pin[0] = pin[1] + PT[0];
#pragma unroll
    for (int g = 0; g < 4; ++g) { const float S = carry + own[g] + (hi == 0 ? pin[g] : pin[g + 1]);
        const float e3 = S, e2 = e3 + ln[4 * g + 3], e1 = e2 + ln[4 * g + 2], e0 = e1 + ln[4 * g + 1];
        p[4 * g + 3] = __builtin_amdgcn_exp2f(p[4 * g + 3] + e3); p[4 * g + 2] = __builtin_amdgcn_exp2f(p[4 * g + 2] + e2);
        p[4 * g + 1] = __builtin_amdgcn_exp2f(p[4 * g + 1] + e1); p[4 * g] = __builtin_amdgcn_exp2f(p[4 * g] + e0); }
    carry += own[0] + T[0] + pin[0];
}
__device__ __forceinline__ void sb_wave(int b, int h, int t0, const bf16_t* SBq, bf16_t* O, LAS unsigned char* Vs, int lane_in) {
    int lane = lane_in; asm volatile("" : "+v"(lane));
    const int r = lane & 31, hi = lane >> 5;
    const size_t rowbase = (size_t)b * SEQ;
    bf16x8 qf[4];
    { const bf16_t* qp = SBq + (rowbase + t0 + r) * 1536 + h * 64 + hi * 8;
#pragma unroll
      for (int ks = 0; ks < 4; ++ks) qf[ks] = *(const bf16x8*)(qp + ks * 16); }
    const bf16_t* Kh = SBq + rowbase * 1536 + 512 + h * 64 + hi * 8;
    const bf16_t* Vh = SBq + rowbase * 1536 + 1024 + h * 64;
    const int va = ((lane >> 4) & 1) * 32 + (lane & 3) * 8 + (4 * hi + ((lane & 15) >> 2)) * 64;
    const int tq = t0 + r, jd = t0 >> 6;
    float R = 0.f; f32x16 o0 = {}, o1 = {};
    for (int j = jd; j >= 0; --j) {
#pragma unroll
        for (int i = 0; i < 8; ++i) { const int row = i * 8 + (lane >> 3), ch = lane & 7;
            const u32x4 v = *(const u32x4*)(Vh + (size_t)(64 * j + row) * 1536 + ch * 8);
            *(LAS u32x4*)(Vs + (ch >> 2) * 4096 + (row >> 3) * 512 + (row & 7) * 64 + (ch & 3) * 16) = v; }
        f32x16 p0 = {}, p1 = {};
#pragma unroll
        for (int ks = 0; ks < 4; ++ks) {
            const bf16x8 a0 = *(const bf16x8*)(Kh + (size_t)(64 * j + r) * 1536 + ks * 16), a1 = *(const bf16x8*)(Kh + (size_t)(64 * j + 32 + r) * 1536 + ks * 16);
            p0 = __builtin_amdgcn_mfma_f32_32x32x16_bf16(a0, qf[ks], p0, 0, 0, 0);
            p1 = __builtin_amdgcn_mfma_f32_32x32x16_bf16(a1, qf[ks], p1, 0, 0, 0);
        }
        const bool diag = (j == jd);
        sb_half(p1, R, 64 * j + 32, hi, tq, diag);
        sb_half(p0, R, 64 * j, hi, tq, diag);
        const bf16x8 pw0 = packp(p0, 0), pw1 = packp(p0, 8), pw2 = packp(p1, 0), pw3 = packp(p1, 8);
        const LAS unsigned char* vp = Vs + va;
        o0 = __builtin_amdgcn_mfma_f32_32x32x16_bf16(vfrag(vp), pw0, o0, 0, 0, 0);
        o1 = __builtin_amdgcn_mfma_f32_32x32x16_bf16(vfrag(vp + 4096), pw0, o1, 0, 0, 0);
        o0 = __builtin_amdgcn_mfma_f32_32x32x16_bf16(vfrag(vp + 1024), pw1, o0, 0, 0, 0);
        o1 = __builtin_amdgcn_mfma_f32_32x32x16_bf16(vfrag(vp + 4096 + 1024), pw1, o1, 0, 0, 0);
        o0 = __builtin_amdgcn_mfma_f32_32x32x16_bf16(vfrag(vp + 2048), pw2, o0, 0, 0, 0);
        o1 = __builtin_amdgcn_mfma_f32_32x32x16_bf16(vfrag(vp + 4096 + 2048), pw2, o1, 0, 0, 0);
        o0 = __builtin_amdgcn_mfma_f32_32x32x16_bf16(vfrag(vp + 3072), pw3, o0, 0, 0, 0);
        o1 = __builtin_amdgcn_mfma_f32_32x32x16_bf16(vfrag(vp + 4096 + 3072), pw3, o1, 0, 0, 0);
        if (__all(R < -32.0f)) break;
    }
    bf16_t* op = O + (rowbase + t0 + r) * 1024 + h * 64 + 4 * hi;
#pragma unroll
    for (int g = 0; g < 4; ++g) {
        u32x2 w0, w1; w0.x = cvtpk(o0[4 * g], o0[4 * g + 1]); w0.y = cvtpk(o0[4 * g + 2], o0[4 * g + 3]);
        w1.x = cvtpk(o1[4 * g], o1[4 * g + 1]); w1.y = cvtpk(o1[4 * g + 2], o1[4 * g + 3]);
        *(u32x2*)(op + 8 * g) = w0; *(u32x2*)(op + 32 + 8 * g) = w1;
    }
}
constexpr int NWAVES = 8, NTHR = 512;
constexpr int M = 4 * SEQ, D = 1024, DFF = 2816, DEPTH = 4;
constexpr int LDS_BYTES = 147456;
constexpr size_t MiB = 1u << 20;
constexpr size_t WS_SSQ = 0, WS_COS = 1 * MiB, WS_SIN = 1 * MiB + 512 * 1024, WS_W = 2 * MiB, WS_XB = 170 * MiB, WS_H = 234 * MiB, WS_Q = 410 * MiB, WS_END = 458 * MiB;
constexpr size_t W_FFN = 8650752, W_FFN_D = 5767168, W_EVEN = 69206016, W_EVEN_SZ = 4784128, W_UQ = 2883584, W_UKV = 3473408, W_MOUT = 3735552, W_ODD = W_EVEN + 2 * W_EVEN_SZ, W_ODD_SZ = 4194304, W_COUT = 3145728;
constexpr float ALPHA = 1.681792830507429f;
constexpr float LOG2E = 1.4426950408889634f;

__device__ __forceinline__ unsigned f2bf(float f) { unsigned u = __builtin_bit_cast(unsigned, f); return (u + 0x7fffu + ((u >> 16) & 1u)) >> 16; }
__device__ __forceinline__ unsigned pk2(float lo, float hi) { return f2bf(lo) | (f2bf(hi) << 16); }
__device__ __forceinline__ float wave_sum(float v) {
#pragma unroll
    for (int o = 1; o < 64; o <<= 1) v += __shfl_xor(v, o);
    return v;
}
__device__ __forceinline__ void transpose_item(const float* W, int K, int N, bf16_t* WT, int k0, int n0, int drow0, const float* gk, LAS float* scr, int lane) {
#pragma unroll 8
    for (int i = 0; i < 32; ++i) { const int kk = 2 * i + (lane >> 5); float v = W[(size_t)(k0 + kk) * N + n0 + (lane & 31)]; if (gk) v *= gk[k0 + kk]; scr[kk * 33 + (lane & 31)] = v; }
    asm volatile("s_waitcnt lgkmcnt(0)" ::: "memory");
    const int c = lane & 7;
#pragma unroll
    for (int j = 0; j < 4; ++j) { const int n = (lane >> 3) + 8 * j; const LAS float* s = scr + (8 * c) * 33 + n;
        u32x4 o; o.x = pk2(s[0 * 33], s[1 * 33]); o.y = pk2(s[2 * 33], s[3 * 33]); o.z = pk2(s[4 * 33], s[5 * 33]); o.w = pk2(s[6 * 33], s[7 * 33]);
        *(u32x4*)(WT + (size_t)(drow0 + n) * K + k0 + 8 * c) = o; }
    asm volatile("s_waitcnt lgkmcnt(0)" ::: "memory");
}

struct Args { const float* in[15]; float* out; unsigned char* ws; float inv_freq[16]; int pad[2]; };

__global__ void __launch_bounds__(NTHR, 2) mega_fwd(Args a) {
    extern __shared__ __attribute__((aligned(16))) unsigned char lds_raw[];
    LAS unsigned char* lds = (LAS unsigned char*)lds_raw;
    cg::grid_group grid = cg::this_grid();
    const int tid = threadIdx.x, lane = tid & 63, wave = __builtin_amdgcn_readfirstlane(tid >> 6);
    const int G = gridDim.x, bx = blockIdx.x, vcu = (G % 8 == 0) ? (bx % 8) * (G / 8) + bx / 8 : bx;
    const int gw = vcu * NWAVES + wave, NGW = G * NWAVES;
    const float* x_in = a.in[0]; const float* ln_g = a.in[1]; const float* ln_b = a.in[2];
    const float* w_gate = a.in[3]; const float* w_up = a.in[4]; const float* w_down = a.in[5];
    const float* mix_w_in = a.in[6]; const float* q_norm_g = a.in[7]; const float* w_uq = a.in[8]; const float* kv_norm_g = a.in[9]; const float* w_ukv = a.in[10]; const float* mix_w_out = a.in[11];
    const float* conv_w_in = a.in[12]; const float* conv_w = a.in[13]; const float* conv_w_out = a.in[14];
    float* out = a.out; unsigned char* ws = a.ws;
    float* ssq_q = (float*)(ws + WS_SSQ); float* ssq_kv = ssq_q + M;
    float* cosT = (float*)(ws + WS_COS); float* sinT = (float*)(ws + WS_SIN);
    bf16_t* Wc = (bf16_t*)(ws + WS_W); bf16_t* XB = (bf16_t*)(ws + WS_XB); bf16_t* H = (bf16_t*)(ws + WS_H); bf16_t* Qb = (bf16_t*)(ws + WS_Q);
    bf16_t* SBb = H; bf16_t* CQ = H + (size_t)M * 1536; bf16_t* CKV = CQ + (size_t)M * 768; bf16_t* KR = CKV + (size_t)M * 256; bf16_t* AO = CQ; bf16_t* KVb = XB;
    bf16_t* Ub = H; bf16_t* GBb = H + (size_t)M * 1024; bf16_t* CA = XB;

    {
        LAS float* scr = (LAS float*)(lds + wave * 16384);
        constexpr int I_FFN = 1408, I_FFNLF = 3 * I_FFN, I_ALLFFN = 8 * I_FFNLF, I_MIN = 1296, I_UQ = 288, I_UKV = 128, I_MOUT = 512, I_EVEN = I_MIN + I_UQ + I_UKV + I_MOUT, I_CIN = 1536, I_COUT = 512, I_ODD = I_CIN + I_COUT;
        constexpr int NITEMS = I_ALLFFN + 2 * I_EVEN + 2 * I_ODD;
        for (int it = gw; it < NITEMS; it += NGW) {
            if (it < I_ALLFFN) {
                const int lf = it / I_FFNLF, r2 = it % I_FFNLF, which = r2 / I_FFN, item = r2 % I_FFN;
                bf16_t* wb = Wc + (size_t)lf * W_FFN;
                if (which < 2) { const int kb = item / 88, nb = item % 88;
                    transpose_item((which == 0 ? w_gate : w_up) + (size_t)lf * D * DFF, D, DFF, wb, 64 * kb, 32 * nb, 256 * (nb >> 2) + 32 * (nb & 3) + (which ? 128 : 0), nullptr, scr, lane); }
                else { const int kb = item / 32, nb = item % 32;
                    transpose_item(w_down + (size_t)lf * DFF * D, DFF, D, wb + W_FFN_D, 64 * kb, 32 * nb, 32 * nb, nullptr, scr, lane); }
            } else if (it < I_ALLFFN + 2 * I_EVEN) {
                const int r1 = it - I_ALLFFN, j = r1 / I_EVEN; int r2 = r1 % I_EVEN;
                bf16_t* wb = Wc + W_EVEN + (size_t)j * W_EVEN_SZ;
                if (r2 < I_MIN) { const int kb = r2 / 81, nb = r2 % 81; transpose_item(mix_w_in + (size_t)j * D * 2592, D, 2592, wb, 64 * kb, 32 * nb, 32 * nb, nullptr, scr, lane); continue; } r2 -= I_MIN;
                if (r2 < I_UQ) { const int kb = r2 / 24, nb = r2 % 24; transpose_item(w_uq + (size_t)j * 768 * 768, 768, 768, wb + W_UQ, 64 * kb, 32 * nb, 32 * nb, q_norm_g + j * 768, scr, lane); continue; } r2 -= I_UQ;
                if (r2 < I_UKV) { const int kb = r2 / 32, nb = r2 % 32; transpose_item(w_ukv + (size_t)j * 256 * 1024, 256, 1024, wb + W_UKV, 64 * kb, 32 * nb, 32 * nb, kv_norm_g + j * 256, scr, lane); continue; } r2 -= I_UKV;
                { const int kb = r2 / 32, nb = r2 % 32; transpose_item(mix_w_out + (size_t)j * D * D, D, D, wb + W_MOUT, 64 * kb, 32 * nb, 32 * nb, nullptr, scr, lane); }
            } else {
                const int r1 = it - I_ALLFFN - 2 * I_EVEN, j = r1 / I_ODD; int r2 = r1 % I_ODD;
                bf16_t* wb = Wc + W_ODD + (size_t)j * W_ODD_SZ;
                if (r2 < I_CIN) { const int kb = r2 / 96, nb = r2 % 96; int drow;
                    if (nb < 32) drow = 256 * (8 + (nb >> 3)) + 32 * (nb & 7);
                    else { const int c = (nb - 32) & 31; drow = 256 * (c >> 2) + 32 * (c & 3) + (nb >= 64 ? 128 : 0); }
                    transpose_item(conv_w_in + (size_t)j * D * 3072, D, 3072, wb, 64 * kb, 32 * nb, drow, nullptr, scr, lane); }
                else { r2 -= I_CIN; const int kb = r2 / 32, nb = r2 % 32; transpose_item(conv_w_out + (size_t)j * D * D, D, D, wb + W_COUT, 64 * kb, 32 * nb, 32 * nb, nullptr, scr, lane); }
            }
        }
        const int gt = vcu * NTHR + tid, NGT = G * NTHR;
        for (int i = gt; i < SEQ * 16; i += NGT) { const int pos = i >> 4, fi = i & 15; const float ang = (float)pos * a.inv_freq[fi];
            const double rev = (double)ang * 0.15915494309189535; const float fr = (float)(rev - floor(rev));
            cosT[i] = __builtin_amdgcn_cosf(fr); sinT[i] = __builtin_amdgcn_sinf(fr); }
        for (size_t i = gt; i < (size_t)M * D / 8; i += NGT) { const f32x4 v0 = ((const f32x4*)x_in)[2 * i], v1 = ((const f32x4*)x_in)[2 * i + 1];
            u32x4 o; o.x = pk2(v0[0], v0[1]); o.y = pk2(v0[2], v0[3]); o.z = pk2(v1[0], v1[1]); o.w = pk2(v1[2], v1[3]); ((u32x4*)XB)[i] = o; }
    }
    grid.sync();

    for (int l = 0; l < DEPTH; ++l) {
        const int j = l >> 1;
        for (int sub = 0; sub < 3; ++sub) {
            if (sub != 1) {
                const int lf = l * 2 + (sub >> 1);
                const bf16_t* wb = Wc + (size_t)lf * W_FFN;
                { pg8::Gemm g{XB, wb, M, 2 * DFF, D}; pg8::StaticOrder S; S.init(M, 2 * DFF, G, bx); pg8::EpiSwiGLU E{H, DFF};
                  pg8::gemm_phase<pg8::EpiSwiGLU, pg8::StaticOrder, PG8_ALIGN, PG8_SP2>(lds, g, S, E); }
                grid.sync();
                { pg8::Gemm g{H, wb + W_FFN_D, M, D, DFF}; pg8::StaticOrder S; S.init(M, D, G, bx); pg8::EpiResid E{(l == 0 && sub == 0) ? x_in : out, out, ALPHA, 0.5f};
                  pg8::gemm_phase<pg8::EpiResid, pg8::StaticOrder, PG8_ALIGN, PG8_SP2>(lds, g, S, E); }
                grid.sync();
            } else if ((l & 1) == 0) {
                const bf16_t* wb = Wc + W_EVEN + (size_t)j * W_EVEN_SZ;
                { pg8::Gemm g{XB, wb, M, 2816, D}; pg8::StaticOrder S; S.init(M, 2816, G, bx); pg8::EpiMixIn E{SBb, CQ, CKV, KR, ssq_q, ssq_kv, cosT, sinT, 0.125f * LOG2E};
                  pg8::gemm_phase<pg8::EpiMixIn, pg8::StaticOrder, PG8_ALIGN, PG8_SP2>(lds, g, S, E); }
                grid.sync();
                { pg8::Gemm g{CQ, wb + W_UQ, M, 768, 768}; pg8::StaticOrder S; S.init(M, 768, G, bx); pg8::EpiQ E{Qb, ssq_q, cosT, sinT, 0.10206207261596575f * LOG2E};
                  pg8::gemm_phase<pg8::EpiQ, pg8::StaticOrder, PG8_ALIGN, PG8_SP2>(lds, g, S, E); }
                { pg8::Gemm g{CKV, wb + W_UKV, M, 1024, 256}; pg8::StaticOrder S; S.init(M, 1024, G, G - 1 - bx); pg8::EpiKV E{KVb, ssq_kv};
                  pg8::gemm_phase<pg8::EpiKV, pg8::StaticOrder, PG8_ALIGN, PG8_SP2>(lds, g, S, E); }
                grid.sync();
                for (int i = 0; i * G + vcu < 1024; ++i) { const int L = i * G + vcu, bh = (L & 255) >> 3, s = L & 7, rd = L >> 8, qb = rd == 0 ? s : rd == 1 ? 15 - s : rd == 2 ? 16 + s : 31 - s;
                    sb_wave(bh >> 3, bh & 7, qb * 256 + wave * 32, SBb, AO, lds + wave * 8192, lane); }
                __syncthreads();
                for (int i = 0; i * G + vcu < 1024; ++i) { const int L = i * G + vcu, bh = (L & 255) >> 3, s = L & 7, rd = L >> 8, qb = rd == 0 ? s : rd == 1 ? 15 - s : rd == 2 ? 16 + s : 31 - s;
                    mla_unit(bh >> 3, bh & 7, qb, Qb, KVb, KR, AO, lds); }
                grid.sync();
                { pg8::Gemm g{AO, wb + W_MOUT, M, D, D}; pg8::StaticOrder S; S.init(M, D, G, bx); pg8::EpiResid E{out, out, ALPHA, 1.0f};
                  pg8::gemm_phase<pg8::EpiResid, pg8::StaticOrder, PG8_ALIGN, PG8_SP2>(lds, g, S, E); }
                grid.sync();
            } else {
                const bf16_t* wb = Wc + W_ODD + (size_t)j * W_ODD_SZ;
                { pg8::Gemm g{XB, wb, M, 3072, D}; pg8::StaticOrder S; S.init(M, 3072, G, bx); pg8::EpiConvIn E{Ub, GBb};
                  pg8::gemm_phase<pg8::EpiConvIn, pg8::StaticOrder, PG8_ALIGN, PG8_SP2>(lds, g, S, E); }
                grid.sync();
                { int tid_l = tid; asm volatile("" : "+v"(tid_l)); const float* cw = conv_w + (size_t)j * 3 * D; const int gt = vcu * NTHR + tid_l, NGT = G * NTHR;
                  for (int idx = gt; idx < M * 128; idx += NGT) { const int row = idx >> 7, c8 = (idx & 127) * 8, t = row & (SEQ - 1);
                    const u32x4 z4 = {0u, 0u, 0u, 0u};
                    const u32x4 u0 = *(const u32x4*)(Ub + (size_t)row * 1024 + c8), u1 = t >= 1 ? *(const u32x4*)(Ub + (size_t)(row - 1) * 1024 + c8) : z4, u2 = t >= 2 ? *(const u32x4*)(Ub + (size_t)(row - 2) * 1024 + c8) : z4;
                    const u32x4 gb = *(const u32x4*)(GBb + (size_t)row * 1024 + c8);
                    float o[8];
#pragma unroll
                    for (int e = 0; e < 8; ++e) { const int sh = (e & 1) * 16; const unsigned msk = 0xffffu;
                        const float fu0 = __builtin_bit_cast(float, ((u0[e >> 1] >> sh) & msk) << 16), fu1 = __builtin_bit_cast(float, ((u1[e >> 1] >> sh) & msk) << 16), fu2 = __builtin_bit_cast(float, ((u2[e >> 1] >> sh) & msk) << 16), fg = __builtin_bit_cast(float, ((gb[e >> 1] >> sh) & msk) << 16);
                        o[e] = fg * (cw[c8 + e] * fu2 + cw[D + c8 + e] * fu1 + cw[2 * D + c8 + e] * fu0); }
                    u32x4 w; w.x = pk2(o[0], o[1]); w.y = pk2(o[2], o[3]); w.z = pk2(o[4], o[5]); w.w = pk2(o[6], o[7]);
                    *(u32x4*)(CA + (size_t)row * 1024 + c8) = w; } }
                grid.sync();
                { pg8::Gemm g{CA, wb + W_COUT, M, D, D}; pg8::StaticOrder S; S.init(M, D, G, bx); pg8::EpiResid E{out, out, ALPHA, 1.0f};
                  pg8::gemm_phase<pg8::EpiResid, pg8::StaticOrder, PG8_ALIGN, PG8_SP2>(lds, g, S, E); }
                grid.sync();
            }
            { int lane_l = lane; asm volatile("" : "+v"(lane_l)); const int lane = lane_l; const float* gp = ln_g + (size_t)(l * 3 + sub) * D; const float* bp = ln_b + (size_t)(l * 3 + sub) * D;
              f32x4 gv[4], bv[4];
#pragma unroll
              for (int q = 0; q < 4; ++q) { gv[q] = ((const f32x4*)gp)[lane + 64 * q]; bv[q] = ((const f32x4*)bp)[lane + 64 * q]; }
              for (int m = gw; m < M; m += NGW) { f32x4* xr = (f32x4*)(out + (size_t)m * D) + lane; f32x4 v[4]; float s = 0.f;
#pragma unroll
                for (int q = 0; q < 4; ++q) { v[q] = xr[64 * q]; s += (v[q][0] + v[q][1]) + (v[q][2] + v[q][3]); }
                const float mean = wave_sum(s) * (1.0f / D); float s2 = 0.f;
#pragma unroll
                for (int q = 0; q < 4; ++q) { v[q] = v[q] - mean; s2 += (v[q][0] * v[q][0] + v[q][1] * v[q][1]) + (v[q][2] * v[q][2] + v[q][3] * v[q][3]); }
                const float rstd = 1.0f / sqrtf(wave_sum(s2) * (1.0f / D) + 1e-5f);
                u32x2* o8 = (u32x2*)(XB + (size_t)m * D) + lane;
#pragma unroll
                for (int q = 0; q < 4; ++q) { const f32x4 y = v[q] * rstd * gv[q] + bv[q]; xr[64 * q] = y; u32x2 w; w.x = pk2(y[0], y[1]); w.y = pk2(y[2], y[3]); o8[64 * q] = w; }
                if (lane == 0) { ssq_q[m] = 0.f; ssq_kv[m] = 0.f; } } }
            if (!(l == DEPTH - 1 && sub == 2)) grid.sync();
        }
    }
}

extern "C" void kernel_launch(void* const* d_in, const int* in_sizes, int n_in, void* d_out, int out_size, void* d_ws, size_t ws_size, hipStream_t stream) {
    static int grid = 0;
    if (grid == 0) {
        if (n_in != 15 || out_size != M * D || ws_size < WS_END) { fprintf(stderr, "kernel_launch: unexpected problem (n_in %d out %d ws %zu)\n", n_in, out_size, ws_size); grid = -1; return; }
        int dev = 0, cus = 0, per_cu = 0;
        hipGetDevice(&dev); hipDeviceGetAttribute(&cus, hipDeviceAttributeMultiprocessorCount, dev);
        if (hipFuncSetAttribute((const void*)mega_fwd, hipFuncAttributeMaxDynamicSharedMemorySize, LDS_BYTES) != hipSuccess) { fprintf(stderr, "kernel_launch: hipFuncSetAttribute failed\n"); grid = -1; return; }
        if (hipOccupancyMaxActiveBlocksPerMultiprocessor(&per_cu, (const void*)mega_fwd, NTHR, LDS_BYTES) != hipSuccess || per_cu < 1) { fprintf(stderr, "kernel_launch: occupancy query says %d\n", per_cu); per_cu = 1; }
        (void)hipGetLastError();
        grid = cus * 1;
    }
    if (grid < 0) return;
    Args a{};
    for (int i = 0; i < 15; ++i) a.in[i] = (const float*)d_in[i];
    a.out = (float*)d_out; a.ws = (unsigned char*)d_ws;
    for (int i = 0; i < 16; ++i) a.inv_freq[i] = powf(10000.0f, -(float)i / 16.0f);
    void* args[] = {&a};
    hipError_t e = hipLaunchCooperativeKernel((const void*)mega_fwd, dim3(grid), dim3(NTHR), args, LDS_BYTES, stream);
    if (e != hipSuccess) fprintf(stderr, "cooperative launch failed: %s (grid %d)\n", hipGetErrorString(e), grid);
}
```

```cpp
#include <hip/hip_runtime.h>
#include <hip/hip_cooperative_groups.h>
#include <cstdio>
#include <cstdint>
#include <cmath>
namespace cg = cooperative_groups;
namespace pg8 {
#define PG8_LAS __attribute__((address_space(3)))
typedef unsigned short bf16_t;
typedef short bf16x8 __attribute__((ext_vector_type(8)));
typedef float f32x4 __attribute__((ext_vector_type(4)));
typedef unsigned u32x4 __attribute__((ext_vector_type(4)));
constexpr int BM = 256, BK = 64, HALF = 128, HTB = HALF * BK * 2  , STAGE_BYTES = 8 * HTB, NXCD = 8, WGM = 8;

__host__ __device__ __forceinline__ int lds_byte(int r, int c) { const int st = (r >> 4) * 2 + (c >> 5), rr = r & 15, cc = c & 31, ob = rr * 64 + cc * 2; return st * 1024 + (ob ^ (((ob >> 9) & 1) << 5)); }
__host__ __device__ __forceinline__ void stage_rc(int b, int& R, int& C) { const int st = b / 1024, sb = b % 1024, swz = sb ^ (((sb >> 9) & 1) << 5); R = (st >> 1) * 16 + swz / 64; C = (st & 1) * 32 + (swz % 64) / 2; }
__host__ __device__ __forceinline__ int perm32(int rho) { const int n = rho >> 4, i = rho & 15; return 8 * (i >> 2) + 4 * n + (i & 3); }

struct Unit { int pm, pn; };
struct Gemm { const bf16_t* A; const bf16_t* Bt; int M, N, K; };

struct StaticOrder {
    int nM, nN, nwg, G, c;
    __host__ __device__ void init(int M, int N, int G_, int c_) { nM = M / BM; nN = N / BM; nwg = nM * nN; G = G_; c = c_; }
    __host__ __device__ bool next(int i, Unit& u) const {
        const long L = (long)i * G + c; if (L >= nwg) return false;
        int wgid = (int)L; { const int q = nwg / NXCD, r = nwg % NXCD, xcd = wgid % NXCD, off = wgid / NXCD; wgid = (xcd < r ? xcd * (q + 1) : r * (q + 1) + (xcd - r) * q) + off; }
        const int nig = WGM * nN, gid = wgid / nig, fm = gid * WGM, gsz = (nM - fm) < WGM ? (nM - fm) : WGM;
        u.pm = fm + ((wgid % nig) % gsz); u.pn = (wgid % nig) / gsz; return true;
    }
    __device__ __forceinline__ void a_ready(const Unit&) const {}
    __device__ __forceinline__ void done(const Unit&) const {}
};

__device__ __forceinline__ unsigned cvt_pk_bf16(float lo, float hi) { unsigned r; asm volatile("v_cvt_pk_bf16_f32 %0, %1, %2" : "=v"(r) : "v"(lo), "v"(hi)); return r; }
typedef unsigned u32x2 __attribute__((ext_vector_type(2)));
__device__ __forceinline__ u32x4 pack8(const f32x4 v0, const f32x4 v1) { u32x4 w; w.x = cvt_pk_bf16(v0[0], v0[1]); w.y = cvt_pk_bf16(v0[2], v0[3]); w.z = cvt_pk_bf16(v1[0], v1[1]); w.w = cvt_pk_bf16(v1[2], v1[3]); return w; }
__device__ __forceinline__ f32x4 shfl32(const f32x4 v) { f32x4 p; p[0] = __shfl_xor(v[0], 32); p[1] = __shfl_xor(v[1], 32); p[2] = __shfl_xor(v[2], 32); p[3] = __shfl_xor(v[3], 32); return p; }
__device__ __forceinline__ f32x4 rope4(const f32x4 v, const float* cosT, const float* sinT, int pos, int fq, int n) {
    const f32x4 p = shfl32(v); const int i0 = (8 * fq + 4 * n) & 15;
    const f32x4 c = *(const f32x4*)(cosT + pos * 16 + i0), s = *(const f32x4*)(sinT + pos * 16 + i0);
    return fq < 2 ? v * c - p * s : v * c + p * s;
}
struct EpiSwiGLU { static constexpr bool PERM = true, AFTER_DRAIN = false; bf16_t* O; int ldc;
    __device__ __forceinline__ void operator()(const f32x4 (&acc)[2][2][4][2], const Unit& u, int wr, int wc, int fr, int fq) const {
        const int row0 = u.pm * BM + wr * 64 + fr, col0 = u.pn * HALF + wc * 32 + 8 * fq;
#pragma unroll
        for (int ai = 0; ai < 2; ++ai)
#pragma unroll
            for (int m = 0; m < 4; ++m) { bf16_t* rowp = O + (size_t)(row0 + ai * HALF + m * 16) * ldc + col0; f32x4 h[2];
#pragma unroll
                for (int n = 0; n < 2; ++n) { const f32x4 g = acc[ai][0][m][n], up = acc[ai][1][m][n];
#pragma unroll
                    for (int e = 0; e < 4; ++e) h[n][e] = g[e] * __builtin_amdgcn_rcpf(1.0f + __builtin_amdgcn_exp2f(-1.4426950408889634f * g[e])) * up[e]; }
                *(u32x4*)rowp = pack8(h[0], h[1]); }
    }
};
struct EpiResid { static constexpr bool PERM = false, AFTER_DRAIN = false; const float* base; float* out; float alpha, s;
    __device__ __forceinline__ void operator()(const f32x4 (&acc)[2][2][4][2], const Unit& u, int wr, int wc, int fr, int fq) const {
        const int row0 = u.pm * BM + wr * 64 + fr, col0 = u.pn * BM + wc * 32 + 4 * fq;
#pragma unroll
        for (int ai = 0; ai < 2; ++ai)
#pragma unroll
            for (int m = 0; m < 4; ++m) { const size_t off = (size_t)(row0 + ai * HALF + m * 16) * 1024 + col0;
#pragma unroll
                for (int bj = 0; bj < 2; ++bj)
#pragma unroll
                    for (int n = 0; n < 2; ++n) { const size_t p = off + bj * HALF + n * 16; const f32x4 bs = *(const f32x4*)(base + p); *(f32x4*)(out + p) = bs * alpha + acc[ai][bj][m][n] * s; }
                asm volatile("" ::: "memory"); }
    }
};
struct EpiMixIn { static constexpr bool PERM = true, AFTER_DRAIN = false;
    bf16_t *sb, *cq, *ckv, *kr; float *ssq_q, *ssq_kv; const float *cosT, *sinT; float qscale;
    __device__ __forceinline__ void operator()(const f32x4 (&acc)[2][2][4][2], const Unit& u, int wr, int wc, int fr, int fq) const {
        const int pn = u.pn, row0 = u.pm * BM + wr * 64 + fr;
        if (pn <= 9) {
            bf16_t* base; int ldc, colt; float sc = 1.f; float* ssq = nullptr;
            if (pn < 6) { base = sb; ldc = 1536; colt = pn * 256; if (pn < 2) sc = qscale; }
            else if (pn < 9) { base = cq; ldc = 768; colt = (pn - 6) * 256; ssq = ssq_q; }
            else { base = ckv; ldc = 256; colt = 0; ssq = ssq_kv; }
            const int col0 = colt + wc * 32 + 8 * fq;
#pragma unroll
            for (int ai = 0; ai < 2; ++ai)
#pragma unroll
                for (int m = 0; m < 4; ++m) { const int r = row0 + ai * HALF + m * 16; bf16_t* rowp = base + (size_t)r * ldc + col0; float ss = 0.f;
#pragma unroll
                    for (int bj = 0; bj < 2; ++bj) { const f32x4 v0 = acc[ai][bj][m][0] * sc, v1 = acc[ai][bj][m][1] * sc;
                        ss += (v0[0] * v0[0] + v0[1] * v0[1]) + (v0[2] * v0[2] + v0[3] * v0[3]) + (v1[0] * v1[0] + v1[1] * v1[1]) + (v1[2] * v1[2] + v1[3] * v1[3]);
                        *(u32x4*)(rowp + bj * HALF) = pack8(v0, v1); }
                    if (ssq) { ss += __shfl_xor(ss, 16); ss += __shfl_xor(ss, 32); if (fq == 0) atomicAdd(ssq + r, ss); } }
        } else if (wc == 0) {
#pragma unroll
            for (int ai = 0; ai < 2; ++ai)
#pragma unroll
                for (int m = 0; m < 4; ++m) { const int r = row0 + ai * HALF + m * 16, pos = r & 8191;
                    const f32x4 v0 = rope4(acc[ai][0][m][0], cosT, sinT, pos, fq, 0), v1 = rope4(acc[ai][0][m][1], cosT, sinT, pos, fq, 1);
                    *(u32x4*)(kr + (size_t)r * 32 + 8 * fq) = pack8(v0, v1); }
        }
    }
};
struct EpiQ { static constexpr bool PERM = true, AFTER_DRAIN = false; bf16_t* Q; const float* ssq; const float *cosT, *sinT; float c2;
    __device__ __forceinline__ void operator()(const f32x4 (&acc)[2][2][4][2], const Unit& u, int wr, int wc, int fr, int fq) const {
        const int row0 = u.pm * BM + wr * 64 + fr, col0 = u.pn * BM + wc * 32 + 8 * fq;
#pragma unroll
        for (int ai = 0; ai < 2; ++ai)
#pragma unroll
            for (int m = 0; m < 4; ++m) { const int r = row0 + ai * HALF + m * 16, pos = r & 8191; const float rs = c2 / sqrtf(ssq[r] * (1.0f / 768.0f) + 1e-6f);
#pragma unroll
                for (int bj = 0; bj < 2; ++bj) { const int G = 8 * u.pn + 4 * bj + wc; f32x4 v0 = acc[ai][bj][m][0] * rs, v1 = acc[ai][bj][m][1] * rs;
                    if (G % 3 == 2) { v0 = rope4(v0, cosT, sinT, pos, fq, 0); v1 = rope4(v1, cosT, sinT, pos, fq, 1); }
                    *(u32x4*)(Q + (size_t)r * 768 + col0 + bj * HALF) = pack8(v0, v1); } }
    }
};
struct EpiKV { static constexpr bool PERM = true, AFTER_DRAIN = false; bf16_t* KV; const float* ssq;
    __device__ __forceinline__ void operator()(const f32x4 (&acc)[2][2][4][2], const Unit& u, int wr, int wc, int fr, int fq) const {
        const int row0 = u.pm * BM + wr * 64 + fr, col0 = u.pn * BM + wc * 32 + 8 * fq;
#pragma unroll
        for (int ai = 0; ai < 2; ++ai)
#pragma unroll
            for (int m = 0; m < 4; ++m) { const int r = row0 + ai * HALF + m * 16; const float rs = 1.0f / sqrtf(ssq[r] * (1.0f / 256.0f) + 1e-6f);
#pragma unroll
                for (int bj = 0; bj < 2; ++bj) *(u32x4*)(KV + (size_t)r * 1024 + col0 + bj * HALF) = pack8(acc[ai][bj][m][0] * rs, acc[ai][bj][m][1] * rs); }
    }
};
struct EpiConvIn { static constexpr bool PERM = true, AFTER_DRAIN = false; bf16_t *U, *GB;
    __device__ __forceinline__ void operator()(const f32x4 (&acc)[2][2][4][2], const Unit& u, int wr, int wc, int fr, int fq) const {
        const int row0 = u.pm * BM + wr * 64 + fr, pn = u.pn;
#pragma unroll
        for (int ai = 0; ai < 2; ++ai)
#pragma unroll
            for (int m = 0; m < 4; ++m) { const size_t r = (size_t)(row0 + ai * HALF + m * 16);
                if (pn < 8) *(u32x4*)(U + r * 1024 + pn * HALF + wc * 32 + 8 * fq) = pack8(acc[ai][0][m][0] * acc[ai][1][m][0], acc[ai][0][m][1] * acc[ai][1][m][1]);
                else {
#pragma unroll
                    for (int bj = 0; bj < 2; ++bj) *(u32x4*)(GB + r * 1024 + (pn - 8) * BM + bj * HALF + wc * 32 + 8 * fq) = pack8(acc[ai][bj][m][0], acc[ai][bj][m][1]); } }
    }
};
template <class Epi, class Sched, bool ALIGN_EPI = false, bool SP2 = false>
__device__ __forceinline__ void gemm_phase(PG8_LAS unsigned char* lds, const Gemm g, const Sched& S, const Epi& E) {
    int tid_l = threadIdx.x; asm volatile("" : "+v"(tid_l)); const int tid = tid_l, wid = __builtin_amdgcn_readfirstlane(tid >> 6), lane = tid & 63, wr = wid >> 2, wc = wid & 3, fr = lane & 15, fq = lane >> 4;
    const int K = g.K, nt = K / BK;
    unsigned voffA[2], voffB[2];
#pragma unroll
    for (int i = 0; i < 2; ++i) { int R, C; stage_rc(tid * 16 + i * 8192, R, C); const int Rb = Epi::PERM ? ((R & ~31) + perm32(R & 31)) : R;
        voffA[i] = (unsigned)(R * K + C) * 2u; voffB[i] = (unsigned)(Rb * K + C) * 2u; }
    const size_t kstep = (size_t)(BK * 2);
    const size_t hstep = (size_t)HALF * K * 2;
    const size_t tstep = 2 * hstep;
    const unsigned ldsw = (unsigned)wid * 1024u;
    const int aoff = lds_byte(wr * 64 + fr, fq * 8), boff = lds_byte(wc * 32 + fr, fq * 8);
#define PG8_SA(b, h) (((b) * 2 + (h)) * HTB)
#define PG8_SB(b, h) ((4 + (b) * 2 + (h)) * HTB)
#define PG8_STAGE(bufoff, gbase, voff) do { _Pragma("unroll") for (int _i = 0; _i < 2; ++_i) \
        __builtin_amdgcn_global_load_lds((const unsigned*)((const char*)(gbase) + (voff)[_i]), (PG8_LAS unsigned*)(lds + (bufoff) + ldsw + _i * 8192), 16, 0, 0); } while (0)
#define PG8_LDA(dst, b, h) do { _Pragma("unroll") for (int m = 0; m < 4; ++m) _Pragma("unroll") for (int k = 0; k < 2; ++k) dst[m][k] = *(const PG8_LAS bf16x8*)(lds + PG8_SA(b, h) + aoff + m * 2048 + k * 1024); } while (0)
#define PG8_LDB(dst, b, h) do { _Pragma("unroll") for (int n = 0; n < 2; ++n) _Pragma("unroll") for (int k = 0; k < 2; ++k) dst[n][k] = *(const PG8_LAS bf16x8*)(lds + PG8_SB(b, h) + boff + n * 2048 + k * 1024); } while (0)
#define PG8_MMA(ai, bj, At, Bt) do { __builtin_amdgcn_s_setprio(1); _Pragma("unroll") for (int m = 0; m < 4; ++m) _Pragma("unroll") for (int n = 0; n < 2; ++n) _Pragma("unroll") for (int k = 0; k < 2; ++k) \
        acc[ai][bj][m][n] = __builtin_amdgcn_mfma_f32_16x16x32_bf16(Bt[n][k], At[m][k], acc[ai][bj][m][n], 0, 0, 0); __builtin_amdgcn_s_setprio(0); } while (0)
#define PG8_WAIT_V(n) asm volatile("s_waitcnt vmcnt(" #n ")" ::: "memory")
#define PG8_WAIT_L(n) asm volatile("s_waitcnt lgkmcnt(" #n ")" ::: "memory")
#define PG8_BAR __builtin_amdgcn_s_barrier()
#define PG8_SCHED __builtin_amdgcn_sched_barrier(0)
    Unit cur, nxt; int ui = 0;
    if (!S.next(0, cur)) return;
    f32x4 acc[2][2][4][2];
#pragma unroll
    for (int a = 0; a < 2; ++a)
#pragma unroll
        for (int b = 0; b < 2; ++b)
#pragma unroll
            for (int m = 0; m < 4; ++m)
#pragma unroll
                for (int n = 0; n < 2; ++n) acc[a][b][m][n] = (f32x4){0.f, 0.f, 0.f, 0.f};
    bf16x8 At[4][2], B0[2][2], B1[2][2];
    const char* cA = (const char*)g.A + (size_t)cur.pm * tstep; const char* cB = (const char*)g.Bt + (size_t)cur.pn * tstep;
    S.a_ready(cur);
    if constexpr (SP2) {
        PG8_STAGE(PG8_SB(0, 0), cB, voffB); PG8_STAGE(PG8_SB(0, 1), cB + hstep, voffB); PG8_STAGE(PG8_SA(0, 0), cA, voffA); PG8_STAGE(PG8_SA(0, 1), cA + hstep, voffA);
        if (wr == 1) PG8_BAR;
        PG8_WAIT_V(2); PG8_BAR;
        PG8_STAGE(PG8_SB(1, 0), cB + kstep, voffB); PG8_STAGE(PG8_SA(1, 0), cA + kstep, voffA); PG8_STAGE(PG8_SB(1, 1), cB + hstep + kstep, voffB);
        PG8_WAIT_V(6); PG8_BAR;
    } else {
        PG8_STAGE(PG8_SB(0, 0), cB, voffB); PG8_STAGE(PG8_SA(0, 0), cA, voffA); PG8_STAGE(PG8_SB(0, 1), cB + hstep, voffB); PG8_STAGE(PG8_SA(0, 1), cA + hstep, voffA);
        if (wr == 1) PG8_BAR;
        PG8_WAIT_V(4); PG8_BAR;
        PG8_STAGE(PG8_SB(1, 0), cB + kstep, voffB); PG8_STAGE(PG8_SA(1, 0), cA + kstep, voffA); PG8_STAGE(PG8_SB(1, 1), cB + hstep + kstep, voffB);
        PG8_WAIT_V(6); PG8_BAR;
    }
    for (;;) {
        const bool has_next = S.next(ui + 1, nxt);
        const char* nA = has_next ? (const char*)g.A + (size_t)nxt.pm * tstep : cA; const char* nB = has_next ? (const char*)g.Bt + (size_t)nxt.pn * tstep : cB;
        for (int t = 0; t < nt; t += 2) {
            const bool last = (t == nt - 2);
            const char* a1 = cA + (size_t)(t + 1) * kstep;
            const char* a2 = last ? nA : cA + (size_t)(t + 2) * kstep; const char* b2 = last ? nB : cB + (size_t)(t + 2) * kstep;
            const char* a3 = a2 + kstep; const char* b3 = b2 + kstep;
            if (last && has_next) S.a_ready(nxt);
            if constexpr (SP2) {
            PG8_LDB(B0, 0, 0); PG8_LDB(B1, 0, 1); PG8_SCHED; PG8_LDA(At, 0, 0); PG8_STAGE(PG8_SA(1, 1), a1 + hstep, voffA);
            PG8_WAIT_V(8); PG8_WAIT_L(0); PG8_BAR; PG8_MMA(0, 0, At, B0); PG8_MMA(0, 1, At, B1); PG8_BAR; PG8_SCHED;
            PG8_LDA(At, 0, 1); PG8_STAGE(PG8_SB(0, 0), b2, voffB); PG8_STAGE(PG8_SB(0, 1), b2 + hstep, voffB); PG8_STAGE(PG8_SA(0, 0), a2, voffA);
            PG8_WAIT_V(8); PG8_WAIT_L(0); PG8_BAR; PG8_MMA(1, 0, At, B0); PG8_MMA(1, 1, At, B1); PG8_BAR; PG8_SCHED;
            PG8_LDB(B0, 1, 0); PG8_LDB(B1, 1, 1); PG8_SCHED; PG8_LDA(At, 1, 0); PG8_STAGE(PG8_SA(0, 1), a2 + hstep, voffA);
            PG8_WAIT_V(8); PG8_WAIT_L(0); PG8_BAR; PG8_MMA(0, 0, At, B0); PG8_MMA(0, 1, At, B1); PG8_BAR; PG8_SCHED;
            PG8_LDA(At, 1, 1); PG8_STAGE(PG8_SB(1, 0), b3, voffB); PG8_STAGE(PG8_SB(1, 1), b3 + hstep, voffB); PG8_STAGE(PG8_SA(1, 0), a3, voffA);
            PG8_WAIT_V(8); PG8_WAIT_L(0); PG8_BAR; PG8_MMA(1, 0, At, B0); PG8_MMA(1, 1, At, B1); PG8_BAR; PG8_SCHED;
            } else {
            PG8_LDB(B0, 0, 0); PG8_SCHED; PG8_LDA(At, 0, 0); PG8_STAGE(PG8_SA(1, 1), a1 + hstep, voffA);
            PG8_WAIT_L(8); PG8_BAR; PG8_WAIT_L(0); PG8_MMA(0, 0, At, B0); PG8_BAR; PG8_SCHED;
            PG8_LDB(B1, 0, 1); PG8_STAGE(PG8_SB(0, 0), b2, voffB);
            PG8_BAR; PG8_WAIT_L(0); PG8_MMA(0, 1, At, B1); PG8_BAR;
            PG8_LDA(At, 0, 1); PG8_STAGE(PG8_SA(0, 0), a2, voffA);
            PG8_BAR; PG8_WAIT_L(0); PG8_MMA(1, 0, At, B0); PG8_BAR; PG8_SCHED;
            PG8_STAGE(PG8_SB(0, 1), b2 + hstep, voffB);
            PG8_WAIT_V(6); PG8_BAR; PG8_MMA(1, 1, At, B1); PG8_BAR;
            PG8_LDB(B0, 1, 0); PG8_SCHED; PG8_LDA(At, 1, 0); PG8_STAGE(PG8_SA(0, 1), a2 + hstep, voffA);
            PG8_WAIT_L(8); PG8_BAR; PG8_WAIT_L(0); PG8_MMA(0, 0, At, B0); PG8_BAR; PG8_SCHED;
            PG8_LDB(B1, 1, 1); PG8_STAGE(PG8_SB(1, 0), b3, voffB);
            PG8_BAR; PG8_WAIT_L(0); PG8_MMA(0, 1, At, B1); PG8_BAR;
            PG8_LDA(At, 1, 1); PG8_STAGE(PG8_SA(1, 0), a3, voffA);
            PG8_BAR; PG8_WAIT_L(0); PG8_MMA(1, 0, At, B0); PG8_BAR; PG8_SCHED;
            PG8_STAGE(PG8_SB(1, 1), b3 + hstep, voffB);
            PG8_WAIT_V(6); PG8_BAR; PG8_MMA(1, 1, At, B1); PG8_BAR;
            }
        }
        if constexpr (ALIGN_EPI) { if (wr == 0) PG8_BAR; }
        if constexpr (!Epi::AFTER_DRAIN) { E(acc, cur, wr, wc, fr, fq); S.done(cur); }
        if (!has_next) break;
#pragma unroll
        for (int a = 0; a < 2; ++a)
#pragma unroll
            for (int b = 0; b < 2; ++b)
#pragma unroll
                for (int m = 0; m < 4; ++m)
#pragma unroll
                    for (int n = 0; n < 2; ++n) acc[a][b][m][n] = (f32x4){0.f, 0.f, 0.f, 0.f};
        cur = nxt; cA = nA; cB = nB; ++ui;
        if constexpr (ALIGN_EPI) { if (wr == 1) PG8_BAR; }
    }
    PG8_WAIT_V(0);
    if constexpr (!ALIGN_EPI) { if (wr == 0) PG8_BAR; }
    PG8_BAR;
    if constexpr (Epi::AFTER_DRAIN) { E.fused(acc, cur, wr, wc, fr, fq, lds, wid, lane); S.done(cur); }
#undef PG8_SA
#undef PG8_SB
#undef PG8_STAGE
#undef PG8_LDA
#undef PG8_LDB
#undef PG8_MMA
#undef PG8_WAIT_V
#undef PG8_WAIT_L
#undef PG8_BAR
#undef PG8_SCHED
}
}
#ifndef PG8_SP2
#define PG8_SP2 true
#endif
#ifndef PG8_ALIGN
#define PG8_ALIGN true
#endif
#define LAS __attribute__((address_space(3)))
typedef unsigned short bf16_t;
typedef short bf16x8 __attribute__((ext_vector_type(8)));
typedef short s16x4 __attribute__((ext_vector_type(4)));
typedef float f32x4 __attribute__((ext_vector_type(4)));
typedef float f32x16 __attribute__((ext_vector_type(16)));
typedef unsigned u32x4 __attribute__((ext_vector_type(4)));
typedef unsigned u32x2 __attribute__((ext_vector_type(2)));
typedef float f32x2_t __attribute__((ext_vector_type(2))); typedef __bf16 bf16x2_t __attribute__((ext_vector_type(2)));
__device__ __forceinline__ unsigned cvtpk(float lo, float hi) { f32x2_t v = {lo, hi}; bf16x2_t b = __builtin_convertvector(v, bf16x2_t); return __builtin_bit_cast(unsigned, b); }
__device__ __forceinline__ s16x4 vtr(const LAS unsigned char* p) { return __builtin_bit_cast(s16x4, __builtin_amdgcn_ds_read_tr16_b64_v4i16((LAS s16x4*)p)); }
__device__ __forceinline__ int crow(int r, int hi) { return (r & 3) + 8 * (r >> 2) + 4 * hi; }
__device__ __forceinline__ bf16x8 packp(const f32x16& p, int b) { u32x4 w; w.x = cvtpk(p[b], p[b + 1]); w.y = cvtpk(p[b + 2], p[b + 3]); w.z = cvtpk(p[b + 4], p[b + 5]); w.w = cvtpk(p[b + 6], p[b + 7]); return __builtin_bit_cast(bf16x8, w); }
__device__ __forceinline__ bf16x8 vfrag(const LAS unsigned char* vp) { const s16x4 lo = vtr(vp), hi = vtr(vp + 512); return (bf16x8){lo[0], lo[1], lo[2], lo[3], hi[0], hi[1], hi[2], hi[3]}; }

constexpr int SEQ = 8192;
constexpr int KP = 208;
constexpr int MLA_KB = 64 * KP, MLA_STAGE = MLA_KB + 8192;

__device__ __forceinline__ void mla_unit(int b, int h, int qb, const bf16_t* Q, const bf16_t* KV, const bf16_t* KR, bf16_t* O, LAS unsigned char* lds) {
    int tid_l = threadIdx.x; asm volatile("" : "+v"(tid_l)); const int tid = tid_l, lane = tid & 63, r = lane & 31, hi = lane >> 5, wid = __builtin_amdgcn_readfirstlane(tid >> 6);
    const size_t rowbase = (size_t)b * SEQ; const int q0 = qb * 256;
    bf16x8 qf[6];
    { const bf16_t* qp = Q + (rowbase + q0 + wid * 32 + r) * 768 + h * 96 + hi * 8;
#pragma unroll
      for (int ks = 0; ks < 6; ++ks) qf[ks] = *(const bf16x8*)(qp + ks * 16); }
    const int NT = 4 * qb + 4;
    const int lrow = tid >> 3, lch = tid & 7;
    const bf16_t* kvsrc = KV + (rowbase + lrow) * 1024 + h * 128 + lch * 8;
    const int kdst = lrow * KP + lch * 16;
    const int vdst = MLA_KB + (lch >> 2) * 4096 + (lrow >> 3) * 512 + (lrow & 7) * 64 + (lch & 3) * 16;
    const int rrow = (tid & 255) >> 2, rch = tid & 3;
    const bf16_t* krsrc = KR + (rowbase + rrow) * 32 + rch * 8;
    const int rdst = rrow * KP + 128 + rch * 16;
    u32x4 kreg, vreg, rreg = {0u, 0u, 0u, 0u};
#define MLA_LOADT(t) do { kreg = *(const u32x4*)(kvsrc + (size_t)(t) * 65536); vreg = *(const u32x4*)(kvsrc + (size_t)(t) * 65536 + 64); if (tid < 256) rreg = *(const u32x4*)(krsrc + (size_t)(t) * 2048); } while (0)
#define MLA_STORET(s) do { *(LAS u32x4*)(lds + (s) * MLA_STAGE + kdst) = kreg; *(LAS u32x4*)(lds + (s) * MLA_STAGE + vdst) = vreg; if (tid < 256) *(LAS u32x4*)(lds + (s) * MLA_STAGE + rdst) = rreg; } while (0)
    MLA_LOADT(0); MLA_STORET(0); __syncthreads();
    float mx = -INFINITY, l = 0.f; f32x16 o0 = {}, o1 = {};
    const int ka = r * KP + hi * 16;
    const int va = MLA_KB + ((lane >> 4) & 1) * 32 + (lane & 3) * 8 + (4 * hi + ((lane & 15) >> 2)) * 64;
    for (int t = 0; t < NT; ++t) {
        const int st = t & 1; const bool more = (t + 1 < NT);
        if (more) MLA_LOADT(t + 1);
        const int jb = t - (NT - 4);
        const bool active = (jb < 0) || (64 * jb <= wid * 32 + 31);
        if (active) {
            const LAS unsigned char* Ks = lds + st * MLA_STAGE;
            f32x16 p0 = {}, p1 = {};
#pragma unroll
            for (int ks = 0; ks < 6; ++ks) {
                const bf16x8 a0 = *(const LAS bf16x8*)(Ks + ka + ks * 32), a1 = *(const LAS bf16x8*)(Ks + ka + 32 * KP + ks * 32);
                p0 = __builtin_amdgcn_mfma_f32_32x32x16_bf16(a0, qf[ks], p0, 0, 0, 0);
                p1 = __builtin_amdgcn_mfma_f32_32x32x16_bf16(a1, qf[ks], p1, 0, 0, 0);
            }
            if (jb >= 0) { const int qrel = wid * 32 + r, kb = 64 * jb + 4 * hi;
#pragma unroll
                for (int i = 0; i < 16; ++i) { const int kv = kb + (i & 3) + 8 * (i >> 2); if (kv > qrel) p0[i] = -INFINITY; if (kv + 32 > qrel) p1[i] = -INFINITY; } }
            float rm = fmaxf(p0[0], p1[0]);
#pragma unroll
            for (int i = 1; i < 16; ++i) rm = fmaxf(rm, fmaxf(p0[i], p1[i]));
            rm = fmaxf(rm, __shfl_xor(rm, 32));
            const float mn = fmaxf(mx, rm), alpha = __builtin_amdgcn_exp2f(mx - mn); mx = mn;
            float sum = 0.f;
#pragma unroll
            for (int i = 0; i < 16; ++i) { p0[i] = __builtin_amdgcn_exp2f(p0[i] - mn); p1[i] = __builtin_amdgcn_exp2f(p1[i] - mn); sum += p0[i] + p1[i]; }
            l = l * alpha + sum;
#pragma unroll
            for (int i = 0; i < 16; ++i) { o0[i] *= alpha; o1[i] *= alpha; }
            const bf16x8 pw0 = packp(p0, 0), pw1 = packp(p0, 8), pw2 = packp(p1, 0), pw3 = packp(p1, 8);
            const LAS unsigned char* vp = Ks + va;
            o0 = __builtin_amdgcn_mfma_f32_32x32x16_bf16(vfrag(vp), pw0, o0, 0, 0, 0);
            o1 = __builtin_amdgcn_mfma_f32_32x32x16_bf16(vfrag(vp + 4096), pw0, o1, 0, 0, 0);
            o0 = __builtin_amdgcn_mfma_f32_32x32x16_bf16(vfrag(vp + 1024), pw1, o0, 0, 0, 0);
            o1 = __builtin_amdgcn_mfma_f32_32x32x16_bf16(vfrag(vp + 4096 + 1024), pw1, o1, 0, 0, 0);
            o0 = __builtin_amdgcn_mfma_f32_32x32x16_bf16(vfrag(vp + 2048), pw2, o0, 0, 0, 0);
            o1 = __builtin_amdgcn_mfma_f32_32x32x16_bf16(vfrag(vp + 4096 + 2048), pw2, o1, 0, 0, 0);
            o0 = __builtin_amdgcn_mfma_f32_32x32x16_bf16(vfrag(vp + 3072), pw3, o0, 0, 0, 0);
            o1 = __builtin_amdgcn_mfma_f32_32x32x16_bf16(vfrag(vp + 4096 + 3072), pw3, o1, 0, 0, 0);
        }
        if (more) MLA_STORET(st ^ 1);
        __syncthreads();
    }
#undef MLA_LOADT
#undef MLA_STORET
    l += __shfl_xor(l, 32);
    const float inv = 1.0f / l;
    bf16_t* op = O + (rowbase + q0 + wid * 32 + r) * 1024 + 512 + h * 64 + 4 * hi;
#pragma unroll
    for (int g = 0; g < 4; ++g) {
        u32x2 w0, w1; w0.x = cvtpk(o0[4 * g] * inv, o0[4 * g + 1] * inv); w0.y = cvtpk(o0[4 * g + 2] * inv, o0[4 * g + 3] * inv);
        w1.x = cvtpk(o1[4 * g] * inv, o1[4 * g + 1] * inv); w1.y = cvtpk(o1[4 * g + 2] * inv, o1[4 * g + 3] * inv);
        *(u32x2*)(op + 8 * g) = w0; *(u32x2*)(op + 32 + 8 * g) = w1;
    }
}

__device__ __forceinline__ void sb_half(f32x16& p, float& carry, int kvb, int hi, int tq, bool diag) {
    float ln[16];
#pragma unroll
    for (int i = 0; i < 16; ++i) { const float y = p[i]; const float sp = fmaxf(y, 0.f) + __builtin_amdgcn_logf(1.0f + __builtin_amdgcn_exp2f(-fabsf(y)));
        float a = -sp, lb = y - sp;
        if (diag) { const bool valid = (kvb + crow(i, hi)) < tq; a = valid ? a : 0.f; lb = valid ? lb : -INFINITY; }
        ln[i] = a; p[i] = lb; }
    float T[4], PT[4];
#pragma unroll
    for (int g = 0; g < 4; ++g) { T[g] = (ln[4 * g] + ln[4 * g + 1]) + (ln[4 * g + 2] + ln[4 * g + 3]); PT[g] = __shfl_xor(T[g], 32); }
    float own[4], pin[5];
    own[3] = 0.f; own[2] = T[3]; own[1] = own[2] + T[2]; own[0] = own[1] + T[1];
    pin[4] = 0.f; pin[3] = PT[3]; pin[2] = pin[3] + PT[2]; pin[1] = pin[2] + PT[1]; pin[0] = pin[1] + PT[0];
#pragma unroll
    for (int g = 0; g < 4; ++g) { const float S = carry + own[g] + (hi == 0 ? pin[g] : pin[g + 1]);
        const float e3 = S, e2 = e3 + ln[4 * g + 3], e1 = e2 + ln[4 * g + 2], e0 = e1 + ln[4 * g + 1];
        p[4 * g + 3] = __builtin_amdgcn_exp2f(p[4 * g + 3] + e3); p[4 * g + 2] = __builtin_amdgcn_exp2f(p[4 * g + 2] + e2);
        p[4 * g + 1] = __builtin_amdgcn_exp2f(p[4 * g + 1] + e1); p[4 * g] = __builtin_amdgcn_exp2f(p[4 * g] + e0); }
    carry += own[0] + T[0] + pin[0];
}
__device__ __forceinline__ void sb_wave(int b, int h, int t0, const bf16_t* SBq, bf16_t* O, LAS unsigned char* Vs, int lane_in) {
    int lane = lane_in; asm volatile("" : "+v"(lane));
    const int r = lane & 31, hi = lane >> 5;
    const size_t rowbase = (size_t)b * SEQ;
    bf16x8 qf[4];
    { const bf16_t* qp = SBq + (rowbase + t0 + r) * 1536 + h * 64 + hi * 8;
#pragma unroll
      for (int ks = 0; ks < 4; ++ks) qf[ks] = *(const bf16x8*)(qp + ks * 16); }
    const bf16_t* Kh = SBq + rowbase * 1536 + 512 + h * 64 + hi * 8;
    const bf16_t* Vh = SBq + rowbase * 1536 + 1024 + h * 64;
    const int va = ((lane >> 4) & 1) * 32 + (lane & 3) * 8 + (4 * hi + ((lane & 15) >> 2)) * 64;
    const int tq = t0 + r, jd = t0 >> 6;
    float R = 0.f; f32x16 o0 = {}, o1 = {};
    for (int j = jd; j >= 0; --j) {
#pragma unroll
        for (int i = 0; i < 8; ++i) { const int row = i * 8 + (lane >> 3), ch = lane & 7;
            const u32x4 v = *(const u32x4*)(Vh + (size_t)(64 * j + row) * 1536 + ch * 8);
            *(LAS u32x4*)(Vs + (ch >> 2) * 4096 + (row >> 3) * 512 + (row & 7) * 64 + (ch & 3) * 16) = v; }
        f32x16 p0 = {}, p1 = {};
#pragma unroll
        for (int ks = 0; ks < 4; ++ks) {
            const bf16x8 a0 = *(const bf16x8*)(Kh + (size_t)(64 * j + r) * 1536 + ks * 16), a1 = *(const bf16x8*)(Kh + (size_t)(64 * j + 32 + r) * 1536 + ks * 16);
            p0 = __builtin_amdgcn_mfma_f32_32x32x16_bf16(a0, qf[ks], p0, 0, 0, 0);
            p1 = __builtin_amdgcn_mfma_f32_32x32x16_bf16(a1, qf[ks], p1, 0, 0, 0);
        }
        const bool diag = (j == jd);
        sb_half(p1, R, 64 * j + 32, hi, tq, diag);
        sb_half(p0, R, 64 * j, hi, tq, diag);
        const bf16x8 pw0 = packp(p0, 0), pw1 = packp(p0, 8), pw2 = packp(p1, 0), pw3 = packp(p1, 8);
        const LAS unsigned char* vp = Vs + va;
        o0 = __builtin_amdgcn_mfma_f32_32x32x16_bf16(vfrag(vp), pw0, o0, 0, 0, 0);
        o1 = __builtin_amdgcn_mfma_f32_32x32x16_bf16(vfrag(vp + 4096), pw0, o1, 0, 0, 0);
        o0 = __builtin_amdgcn_mfma_f32_32x32x16_bf16(vfrag(vp + 1024), pw1, o0, 0, 0, 0);
        o1 = __builtin_amdgcn_mfma_f32_32x32x16_bf16(vfrag(vp + 4096 + 1024), pw1, o1, 0, 0, 0);
        o0 = __builtin_amdgcn_mfma_f32_32x32x16_bf16(vfrag(vp + 2048), pw2, o0, 0, 0, 0);
        o1 = __builtin_amdgcn_mfma_f32_32x32x16_bf16(vfrag(vp + 4096 + 2048), pw2, o1, 0, 0, 0);
        o0 = __builtin_amdgcn_mfma_f32_32x32x16_bf16(vfrag(vp + 3072), pw3, o0, 0, 0, 0);
        o1 = __builtin_amdgcn_mfma_f32_32x32x16_bf16(vfrag(vp + 4096 + 3072), pw3, o1, 0, 0, 0);
        if (__all(R < -32.0f)) break;
    }
    bf16_t* op = O + (rowbase + t0 + r) * 1024 + h * 64 + 4 * hi;
#pragma unroll
    for (int g = 0; g < 4; ++g) {
        u32x2 w0, w1; w0.x = cvtpk(o0[4 * g], o0[4 * g + 1]); w0.y = cvtpk(o0[4 * g + 2], o0[4 * g + 3]);
        w1.x = cvtpk(o1[4 * g], o1[4 * g + 1]); w1.y = cvtpk(o1[4 * g + 2], o1[4 * g + 3]);
        *(u32x2*)(op + 8 * g) = w0; *(u32x2*)(op + 32 + 8 * g) = w1;
    }
}
#define XB_TMO      128
#define XB_XCNT(j)  (256  + 64 * (j))
#define XB_XSUB(j)  (1280 + 64 * (j))
#define XB_XGEN(j)  (2304 + 64 * (j))
#define XB_TOP      3328
#define XB_TOPGEN   3392
#define XCD_BAR_WORDS 3456
#define XB_SPIN_CAP (1u << 18)

__device__ __forceinline__ unsigned xb_ld(unsigned* p)              { return __hip_atomic_load(p, __ATOMIC_RELAXED, __HIP_MEMORY_SCOPE_AGENT); }
__device__ __forceinline__ unsigned xb_add(unsigned* p, unsigned v) { return __hip_atomic_fetch_add(p, v, __ATOMIC_RELAXED, __HIP_MEMORY_SCOPE_AGENT); }
__device__ __forceinline__ unsigned xb_xcc_id() { return (unsigned)__builtin_amdgcn_s_getreg((3 << 11) | 20) & 0xFu; }
#define XB_SPIN(cond, bar) do { unsigned _sp = 0; while (cond) { __builtin_amdgcn_s_sleep(1); \
    if ((++_sp & 255u) == 0u) { if (xb_ld(&(bar)[XB_TMO])) break; if (_sp > XB_SPIN_CAP) { atomicAdd(&(bar)[XB_TMO], 1u); break; } } } } while (0)

struct XcdBarrier {
    unsigned* bar; unsigned x;
    volatile LAS unsigned* st;
};

__device__ __forceinline__ XcdBarrier xcd_barrier_post(unsigned* bar, volatile LAS unsigned* st) {
    XcdBarrier b; b.bar = bar; b.x = xb_xcc_id(); b.st = st;
    if (threadIdx.x == 0) (void)xb_add(&bar[XB_XCNT(b.x)], 1u);
    return b;
}
__device__ __forceinline__ void xcd_barrier_complete(unsigned* bar, unsigned x, unsigned& nloc, unsigned& nx) {
    const unsigned G = gridDim.x * gridDim.y * gridDim.z;
    unsigned sum, cnt, mine, sp = 0u;
    for (;;) {
        sum = 0u; cnt = 0u; mine = 0u;
#pragma unroll
        for (unsigned j = 0; j < 16; ++j) { const unsigned c = xb_ld(&bar[XB_XCNT(j)]); sum += c; cnt += (c > 0u) ? 1u : 0u; mine = (j == x) ? c : mine; }
        if (sum == G) break;
        __builtin_amdgcn_s_sleep(1);
        if ((++sp & 255u) == 0u) { if (xb_ld(&bar[XB_TMO])) break; if (sp > XB_SPIN_CAP) { atomicAdd(&bar[XB_TMO], 1u); break; } }
    }
    nloc = mine > 0u ? mine : 1u; nx = cnt > 0u ? cnt : 1u;
}

__device__ __forceinline__ void xcd_barrier(const XcdBarrier& b) {
    asm volatile("s_waitcnt vmcnt(0)" ::: "memory");
    __syncthreads();
    if (threadIdx.x == 0) {
        unsigned* bar = b.bar;
        __builtin_amdgcn_s_waitcnt(0);
        unsigned nloc = b.st[0], nx = b.st[1];
        if (nloc == 0u) { xcd_barrier_complete(bar, b.x, nloc, nx); b.st[0] = nloc; b.st[1] = nx; }
        const unsigned old = xb_add(&bar[XB_XSUB(b.x)], 1u);
        const unsigned gen = old / nloc;
        if (old + 1u == (gen + 1u) * nloc) {
            __builtin_amdgcn_fence(__ATOMIC_RELEASE, "agent");
            asm volatile("s_waitcnt vmcnt(0)" ::: "memory");
            const unsigned og = xb_add(&bar[XB_TOP], 1u);
            const unsigned tg = og / nx;
            if (og + 1u == (tg + 1u) * nx) xb_add(&bar[XB_TOPGEN], 1u);
            else XB_SPIN(xb_ld(&bar[XB_TOPGEN]) == tg, bar);
            __builtin_amdgcn_fence(__ATOMIC_ACQUIRE, "agent");
            xb_add(&bar[XB_XGEN(b.x)], 1u);
            asm volatile("s_waitcnt vmcnt(0)" ::: "memory");
        } else {
            XB_SPIN(xb_ld(&bar[XB_XGEN(b.x)]) == gen, bar);
            __builtin_amdgcn_fence(__ATOMIC_ACQUIRE, "agent");
            asm volatile("s_waitcnt vmcnt(0)" ::: "memory");
        }
    }
    __syncthreads();
}

constexpr int NWAVES = 8, NTHR = 512;
constexpr int M = 4 * SEQ, D = 1024, DFF = 2816, DEPTH = 4;
constexpr int LDS_BYTES = 147456;
constexpr size_t MiB = 1u << 20;
constexpr size_t WS_BAR = 512 * 1024, WS_BAR_BYTES = 16384; constexpr int MISC_OFF = 131072 + 320;
constexpr size_t WS_SSQ = 0, WS_COS = 1 * MiB, WS_SIN = 1 * MiB + 512 * 1024, WS_W = 2 * MiB, WS_XB = 170 * MiB, WS_H = 234 * MiB, WS_Q = 410 * MiB, WS_END = 458 * MiB;
constexpr size_t W_FFN = 8650752, W_FFN_D = 5767168, W_EVEN = 69206016, W_EVEN_SZ = 4784128, W_UQ = 2883584, W_UKV = 3473408, W_MOUT = 3735552, W_ODD = W_EVEN + 2 * W_EVEN_SZ, W_ODD_SZ = 4194304, W_COUT = 3145728;
constexpr float ALPHA = 1.681792830507429f;
constexpr float LOG2E = 1.4426950408889634f;

__device__ __forceinline__ unsigned f2bf(float f) { unsigned u = __builtin_bit_cast(unsigned, f); return (u + 0x7fffu + ((u >> 16) & 1u)) >> 16; }
__device__ __forceinline__ unsigned pk2(float lo, float hi) { return f2bf(lo) | (f2bf(hi) << 16); }
__device__ __forceinline__ float wave_sum(float v) {
#pragma unroll
    for (int o = 1; o < 64; o <<= 1) v += __shfl_xor(v, o);
    return v;
}
__device__ __forceinline__ void transpose_item(const float* W, int K, int N, bf16_t* WT, int k0, int n0, int drow0, const float* gk, LAS float* scr, int lane) {
#pragma unroll 8
    for (int i = 0; i < 32; ++i) { const int kk = 2 * i + (lane >> 5); float v = W[(size_t)(k0 + kk) * N + n0 + (lane & 31)]; if (gk) v *= gk[k0 + kk]; scr[kk * 33 + (lane & 31)] = v; }
    asm volatile("s_waitcnt lgkmcnt(0)" ::: "memory");
    const int c = lane & 7;
#pragma unroll
    for (int j = 0; j < 4; ++j) { const int n = (lane >> 3) + 8 * j; const LAS float* s = scr + (8 * c) * 33 + n;
        u32x4 o; o.x = pk2(s[0 * 33], s[1 * 33]); o.y = pk2(s[2 * 33], s[3 * 33]); o.z = pk2(s[4 * 33], s[5 * 33]); o.w = pk2(s[6 * 33], s[7 * 33]);
        *(u32x4*)(WT + (size_t)(drow0 + n) * K + k0 + 8 * c) = o; }
    asm volatile("s_waitcnt lgkmcnt(0)" ::: "memory");
}

struct Args { const float* in[15]; float* out; unsigned char* ws; float inv_freq[16]; int pad[2]; };

__global__ void __launch_bounds__(NTHR, 2) mega_fwd(Args a) {
    extern __shared__ __attribute__((aligned(16))) unsigned char lds_raw[];
    LAS unsigned char* lds = (LAS unsigned char*)lds_raw;
    cg::grid_group grid = cg::this_grid();
    const int tid = threadIdx.x, lane = tid & 63, wave = __builtin_amdgcn_readfirstlane(tid >> 6);
    const int G = gridDim.x, bx = blockIdx.x, vcu = (G % 8 == 0) ? (bx % 8) * (G / 8) + bx / 8 : bx;
    const int gw = vcu * NWAVES + wave, NGW = G * NWAVES;
    if (tid < 64) ((LAS unsigned*)(lds + 131072))[tid * 2] = 0u, ((LAS unsigned*)(lds + 131072))[tid * 2 + 1] = 0u;
    __syncthreads();
    XcdBarrier xbar = xcd_barrier_post((unsigned*)(a.ws + WS_BAR), (volatile LAS unsigned*)(lds + MISC_OFF) + 8);
    const float* x_in = a.in[0]; const float* ln_g = a.in[1]; const float* ln_b = a.in[2];
    const float* w_gate = a.in[3]; const float* w_up = a.in[4]; const float* w_down = a.in[5];
    const float* mix_w_in = a.in[6]; const float* q_norm_g = a.in[7]; const float* w_uq = a.in[8]; const float* kv_norm_g = a.in[9]; const float* w_ukv = a.in[10]; const float* mix_w_out = a.in[11];
    const float* conv_w_in = a.in[12]; const float* conv_w = a.in[13]; const float* conv_w_out = a.in[14];
    float* out = a.out; unsigned char* ws = a.ws;
    float* ssq_q = (float*)(ws + WS_SSQ); float* ssq_kv = ssq_q + M;
    float* cosT = (float*)(ws + WS_COS); float* sinT = (float*)(ws + WS_SIN);
    bf16_t* Wc = (bf16_t*)(ws + WS_W); bf16_t* XB = (bf16_t*)(ws + WS_XB); bf16_t* H = (bf16_t*)(ws + WS_H); bf16_t* Qb = (bf16_t*)(ws + WS_Q);
    bf16_t* SBb = H; bf16_t* CQ = H + (size_t)M * 1536; bf16_t* CKV = CQ + (size_t)M * 768; bf16_t* KR = CKV + (size_t)M * 256; bf16_t* AO = CQ; bf16_t* KVb = XB;
    bf16_t* Ub = H; bf16_t* GBb = H + (size_t)M * 1024; bf16_t* CA = XB;

    {
        LAS float* scr = (LAS float*)(lds + wave * 16384);
        constexpr int I_FFN = 1408, I_FFNLF = 3 * I_FFN, I_ALLFFN = 8 * I_FFNLF, I_MIN = 1296, I_UQ = 288, I_UKV = 128, I_MOUT = 512, I_EVEN = I_MIN + I_UQ + I_UKV + I_MOUT, I_CIN = 1536, I_COUT = 512, I_ODD = I_CIN + I_COUT;
        constexpr int NITEMS = I_ALLFFN + 2 * I_EVEN + 2 * I_ODD;
        for (int it = gw; it < NITEMS; it += NGW) {
            if (it < I_ALLFFN) {
                const int lf = it / I_FFNLF, r2 = it % I_FFNLF, which = r2 / I_FFN, item = r2 % I_FFN;
                bf16_t* wb = Wc + (size_t)lf * W_FFN;
                if (which < 2) { const int kb = item / 88, nb = item % 88;
                    transpose_item((which == 0 ? w_gate : w_up) + (size_t)lf * D * DFF, D, DFF, wb, 64 * kb, 32 * nb, 256 * (nb >> 2) + 32 * (nb & 3) + (which ? 128 : 0), nullptr, scr, lane); }
                else { const int kb = item / 32, nb = item % 32;
                    transpose_item(w_down + (size_t)lf * DFF * D, DFF, D, wb + W_FFN_D, 64 * kb, 32 * nb, 32 * nb, nullptr, scr, lane); }
            } else if (it < I_ALLFFN + 2 * I_EVEN) {
                const int r1 = it - I_ALLFFN, j = r1 / I_EVEN; int r2 = r1 % I_EVEN;
                bf16_t* wb = Wc + W_EVEN + (size_t)j * W_EVEN_SZ;
                if (r2 < I_MIN) { const int kb = r2 / 81, nb = r2 % 81; transpose_item(mix_w_in + (size_t)j * D * 2592, D, 2592, wb, 64 * kb, 32 * nb, 32 * nb, nullptr, scr, lane); continue; } r2 -= I_MIN;
                if (r2 < I_UQ) { const int kb = r2 / 24, nb = r2 % 24; transpose_item(w_uq + (size_t)j * 768 * 768, 768, 768, wb + W_UQ, 64 * kb, 32 * nb, 32 * nb, q_norm_g + j * 768, scr, lane); continue; } r2 -= I_UQ;
                if (r2 < I_UKV) { const int kb = r2 / 32, nb = r2 % 32; transpose_item(w_ukv + (size_t)j * 256 * 1024, 256, 1024, wb + W_UKV, 64 * kb, 32 * nb, 32 * nb, kv_norm_g + j * 256, scr, lane); continue; } r2 -= I_UKV;
                { const int kb = r2 / 32, nb = r2 % 32; transpose_item(mix_w_out + (size_t)j * D * D, D, D, wb + W_MOUT, 64 * kb, 32 * nb, 32 * nb, nullptr, scr, lane); }
            } else {
                const int r1 = it - I_ALLFFN - 2 * I_EVEN, j = r1 / I_ODD; int r2 = r1 % I_ODD;
                bf16_t* wb = Wc + W_ODD + (size_t)j * W_ODD_SZ;
                if (r2 < I_CIN) { const int kb = r2 / 96, nb = r2 % 96; int drow;
                    if (nb < 32) drow = 256 * (8 + (nb >> 3)) + 32 * (nb & 7);
                    else { const int c = (nb - 32) & 31; drow = 256 * (c >> 2) + 32 * (c & 3) + (nb >= 64 ? 128 : 0); }
                    transpose_item(conv_w_in + (size_t)j * D * 3072, D, 3072, wb, 64 * kb, 32 * nb, drow, nullptr, scr, lane); }
                else { r2 -= I_CIN; const int kb = r2 / 32, nb = r2 % 32; transpose_item(conv_w_out + (size_t)j * D * D, D, D, wb + W_COUT, 64 * kb, 32 * nb, 32 * nb, nullptr, scr, lane); }
            }
        }
        const int gt = vcu * NTHR + tid, NGT = G * NTHR;
        for (int i = gt; i < SEQ * 16; i += NGT) { const int pos = i >> 4, fi = i & 15; const float ang = (float)pos * a.inv_freq[fi];
            const double rev = (double)ang * 0.15915494309189535; const float fr = (float)(rev - floor(rev));
            cosT[i] = __builtin_amdgcn_cosf(fr); sinT[i] = __builtin_amdgcn_sinf(fr); }
        for (size_t i = gt; i < (size_t)M * D / 8; i += NGT) { const f32x4 v0 = ((const f32x4*)x_in)[2 * i], v1 = ((const f32x4*)x_in)[2 * i + 1];
            u32x4 o; o.x = pk2(v0[0], v0[1]); o.y = pk2(v0[2], v0[3]); o.z = pk2(v1[0], v1[1]); o.w = pk2(v1[2], v1[3]); ((u32x4*)XB)[i] = o; }
    }
    grid.sync();

    for (int l = 0; l < DEPTH; ++l) {
        const int j = l >> 1;
        for (int sub = 0; sub < 3; ++sub) {
            if (sub != 1) {
                const int lf = l * 2 + (sub >> 1);
                const bf16_t* wb = Wc + (size_t)lf * W_FFN;
                { pg8::Gemm g{XB, wb, M, 2 * DFF, D}; pg8::StaticOrder S; S.init(M, 2 * DFF, G, bx); pg8::EpiSwiGLU E{H, DFF};
                  pg8::gemm_phase<pg8::EpiSwiGLU, pg8::StaticOrder, PG8_ALIGN, PG8_SP2>(lds, g, S, E); }
                xcd_barrier(xbar);
                { pg8::Gemm g{H, wb + W_FFN_D, M, D, DFF}; pg8::StaticOrder S; S.init(M, D, G, bx); pg8::EpiResid E{(l == 0 && sub == 0) ? x_in : out, out, ALPHA, 0.5f};
                  pg8::gemm_phase<pg8::EpiResid, pg8::StaticOrder, PG8_ALIGN, PG8_SP2>(lds, g, S, E); }
                xcd_barrier(xbar);
            } else if ((l & 1) == 0) {
                const bf16_t* wb = Wc + W_EVEN + (size_t)j * W_EVEN_SZ;
                { pg8::Gemm g{XB, wb, M, 2816, D}; pg8::StaticOrder S; S.init(M, 2816, G, bx); pg8::EpiMixIn E{SBb, CQ, CKV, KR, ssq_q, ssq_kv, cosT, sinT, 0.125f * LOG2E};
                  pg8::gemm_phase<pg8::EpiMixIn, pg8::StaticOrder, PG8_ALIGN, PG8_SP2>(lds, g, S, E); }
                xcd_barrier(xbar);
                { pg8::Gemm g{CQ, wb + W_UQ, M, 768, 768}; pg8::StaticOrder S; S.init(M, 768, G, bx); pg8::EpiQ E{Qb, ssq_q, cosT, sinT, 0.10206207261596575f * LOG2E};
                  pg8::gemm_phase<pg8::EpiQ, pg8::StaticOrder, PG8_ALIGN, PG8_SP2>(lds, g, S, E); }
                { pg8::Gemm g{CKV, wb + W_UKV, M, 1024, 256}; pg8::StaticOrder S; S.init(M, 1024, G, G - 1 - bx); pg8::EpiKV E{KVb, ssq_kv};
                  pg8::gemm_phase<pg8::EpiKV, pg8::StaticOrder, PG8_ALIGN, PG8_SP2>(lds, g, S, E); }
                xcd_barrier(xbar);
                for (int i = 0; i * G + vcu < 1024; ++i) { const int L = i * G + vcu, bh = (L & 255) >> 3, s = L & 7, rd = L >> 8, qb = rd == 0 ? s : rd == 1 ? 15 - s : rd == 2 ? 16 + s : 31 - s;
                    sb_wave(bh >> 3, bh & 7, qb * 256 + wave * 32, SBb, AO, lds + wave * 8192, lane); }
                __syncthreads();
                for (int i = 0; i * G + vcu < 1024; ++i) { const int L = i * G + vcu, bh = (L & 255) >> 3, s = L & 7, rd = L >> 8, qb = rd == 0 ? s : rd == 1 ? 15 - s : rd == 2 ? 16 + s : 31 - s;
                    mla_unit(bh >> 3, bh & 7, qb, Qb, KVb, KR, AO, lds); }
                xcd_barrier(xbar);
                { pg8::Gemm g{AO, wb + W_MOUT, M, D, D}; pg8::StaticOrder S; S.init(M, D, G, bx); pg8::EpiResid E{out, out, ALPHA, 1.0f};
                  pg8::gemm_phase<pg8::EpiResid, pg8::StaticOrder, PG8_ALIGN, PG8_SP2>(lds, g, S, E); }
                xcd_barrier(xbar);
            } else {
                const bf16_t* wb = Wc + W_ODD + (size_t)j * W_ODD_SZ;
                { pg8::Gemm g{XB, wb, M, 3072, D}; pg8::StaticOrder S; S.init(M, 3072, G, bx); pg8::EpiConvIn E{Ub, GBb};
                  pg8::gemm_phase<pg8::EpiConvIn, pg8::StaticOrder, PG8_ALIGN, PG8_SP2>(lds, g, S, E); }
                xcd_barrier(xbar);
                { int tid_l = tid; asm volatile("" : "+v"(tid_l)); const float* cw = conv_w + (size_t)j * 3 * D; const int gt = vcu * NTHR + tid_l, NGT = G * NTHR;
                  for (int idx = gt; idx < M * 128; idx += NGT) { const int row = idx >> 7, c8 = (idx & 127) * 8, t = row & (SEQ - 1);
                    const u32x4 z4 = {0u, 0u, 0u, 0u};
                    const u32x4 u0 = *(const u32x4*)(Ub + (size_t)row * 1024 + c8), u1 = t >= 1 ? *(const u32x4*)(Ub + (size_t)(row - 1) * 1024 + c8) : z4, u2 = t >= 2 ? *(const u32x4*)(Ub + (size_t)(row - 2) * 1024 + c8) : z4;
                    const u32x4 gb = *(const u32x4*)(GBb + (size_t)row * 1024 + c8);
                    float o[8];
#pragma unroll
                    for (int e = 0; e < 8; ++e) { const int sh = (e & 1) * 16; const unsigned msk = 0xffffu;
                        const float fu0 = __builtin_bit_cast(float, ((u0[e >> 1] >> sh) & msk) << 16), fu1 = __builtin_bit_cast(float, ((u1[e >> 1] >> sh) & msk) << 16), fu2 = __builtin_bit_cast(float, ((u2[e >> 1] >> sh) & msk) << 16), fg = __builtin_bit_cast(float, ((gb[e >> 1] >> sh) & msk) << 16);
                        o[e] = fg * (cw[c8 + e] * fu2 + cw[D + c8 + e] * fu1 + cw[2 * D + c8 + e] * fu0); }
                    u32x4 w; w.x = pk2(o[0], o[1]); w.y = pk2(o[2], o[3]); w.z = pk2(o[4], o[5]); w.w = pk2(o[6], o[7]);
                    *(u32x4*)(CA + (size_t)row * 1024 + c8) = w; } }
                xcd_barrier(xbar);
                { pg8::Gemm g{CA, wb + W_COUT, M, D, D}; pg8::StaticOrder S; S.init(M, D, G, bx); pg8::EpiResid E{out, out, ALPHA, 1.0f};
                  pg8::gemm_phase<pg8::EpiResid, pg8::StaticOrder, PG8_ALIGN, PG8_SP2>(lds, g, S, E); }
                xcd_barrier(xbar);
            }
            { int lane_l = lane; asm volatile("" : "+v"(lane_l)); const int lane = lane_l; const float* gp = ln_g + (size_t)(l * 3 + sub) * D; const float* bp = ln_b + (size_t)(l * 3 + sub) * D;
              f32x4 gv[4], bv[4];
#pragma unroll
              for (int q = 0; q < 4; ++q) { gv[q] = ((const f32x4*)gp)[lane + 64 * q]; bv[q] = ((const f32x4*)bp)[lane + 64 * q]; }
              for (int m = gw; m < M; m += NGW) { f32x4* xr = (f32x4*)(out + (size_t)m * D) + lane; f32x4 v[4]; float s = 0.f;
#pragma unroll
                for (int q = 0; q < 4; ++q) { v[q] = xr[64 * q]; s += (v[q][0] + v[q][1]) + (v[q][2] + v[q][3]); }
                const float mean = wave_sum(s) * (1.0f / D); float s2 = 0.f;
#pragma unroll
                for (int q = 0; q < 4; ++q) { v[q] = v[q] - mean; s2 += (v[q][0] * v[q][0] + v[q][1] * v[q][1]) + (v[q][2] * v[q][2] + v[q][3] * v[q][3]); }
                const float rstd = 1.0f / sqrtf(wave_sum(s2) * (1.0f / D) + 1e-5f);
                u32x2* o8 = (u32x2*)(XB + (size_t)m * D) + lane;
#pragma unroll
                for (int q = 0; q < 4; ++q) { const f32x4 y = v[q] * rstd * gv[q] + bv[q]; xr[64 * q] = y; u32x2 w; w.x = pk2(y[0], y[1]); w.y = pk2(y[2], y[3]); o8[64 * q] = w; }
                if (lane == 0) { ssq_q[m] = 0.f; ssq_kv[m] = 0.f; } } }
            if (!(l == DEPTH - 1 && sub == 2)) xcd_barrier(xbar);
        }
    }
}

extern "C" void kernel_launch(void* const* d_in, const int* in_sizes, int n_in, void* d_out, int out_size, void* d_ws, size_t ws_size, hipStream_t stream) {
    static int grid = 0;
    if (grid == 0) {
        if (n_in != 15 || out_size != M * D || ws_size < WS_END) { fprintf(stderr, "kernel_launch: unexpected problem (n_in %d out %d ws %zu)\n", n_in, out_size, ws_size); grid = -1; return; }
        int dev = 0, cus = 0, per_cu = 0;
        hipGetDevice(&dev); hipDeviceGetAttribute(&cus, hipDeviceAttributeMultiprocessorCount, dev);
        if (hipFuncSetAttribute((const void*)mega_fwd, hipFuncAttributeMaxDynamicSharedMemorySize, LDS_BYTES) != hipSuccess) { fprintf(stderr, "kernel_launch: hipFuncSetAttribute failed\n"); grid = -1; return; }
        if (hipOccupancyMaxActiveBlocksPerMultiprocessor(&per_cu, (const void*)mega_fwd, NTHR, LDS_BYTES) != hipSuccess || per_cu < 1) { fprintf(stderr, "kernel_launch: occupancy query says %d\n", per_cu); per_cu = 1; }
        (void)hipGetLastError();
        grid = cus * 1;
    }
    if (grid < 0) return;
    Args a{};
    for (int i = 0; i < 15; ++i) a.in[i] = (const float*)d_in[i];
    a.out = (float*)d_out; a.ws = (unsigned char*)d_ws;
    for (int i = 0; i < 16; ++i) a.inv_freq[i] = powf(10000.0f, -(float)i / 16.0f);
    (void)hipMemsetAsync((char*)d_ws + WS_BAR, 0, WS_BAR_BYTES, stream);
    void* args[] = {&a};
    hipError_t e = hipLaunchCooperativeKernel((const void*)mega_fwd, dim3(grid), dim3(NTHR), args, LDS_BYTES, stream);
    if (e != hipSuccess) fprintf(stderr, "cooperative launch failed: %s (grid %d)\n", hipGetErrorString(e), grid);
}
```

```cpp
#include <hip/hip_runtime.h>
#include <hip/hip_cooperative_groups.h>
#include <cstdio>
#include <cstdint>
#include <cmath>
namespace cg = cooperative_groups;
__device__ __forceinline__ int fresh_lane() { int x; asm volatile("v_mbcnt_lo_u32_b32 %0, -1, 0\n\tv_mbcnt_hi_u32_b32 %0, -1, %0" : "=v"(x)); return x; }
namespace pg8 {
#define PG8_LAS __attribute__((address_space(3)))
typedef unsigned short bf16_t;
typedef short bf16x8 __attribute__((ext_vector_type(8)));
typedef float f32x4 __attribute__((ext_vector_type(4)));
typedef unsigned u32x4 __attribute__((ext_vector_type(4)));
constexpr int BM = 256, BK = 64, HALF = 128, HTB = HALF * BK * 2  , STAGE_BYTES = 8 * HTB, NXCD = 8, WGM = 8;

__host__ __device__ __forceinline__ int lds_byte(int r, int c) { const int st = (r >> 4) * 2 + (c >> 5), rr = r & 15, cc = c & 31, ob = rr * 64 + cc * 2; return st * 1024 + (ob ^ (((ob >> 9) & 1) << 5)); }
__host__ __device__ __forceinline__ void stage_rc(int b, int& R, int& C) { const int st = b / 1024, sb = b % 1024, swz = sb ^ (((sb >> 9) & 1) << 5); R = (st >> 1) * 16 + swz / 64; C = (st & 1) * 32 + (swz % 64) / 2; }
__host__ __device__ __forceinline__ int perm32(int rho) { const int n = rho >> 4, i = rho & 15; return 8 * (i >> 2) + 4 * n + (i & 3); }

struct Unit { int pm, pn; };
struct Gemm { const bf16_t* A; const bf16_t* Bt; int M, N, K; };

struct StaticOrder {
    int nM, nN, nwg, G, c;
    __host__ __device__ void init(int M, int N, int G_, int c_) { nM = M / BM; nN = N / BM; nwg = nM * nN; G = G_; c = c_; }
    __host__ __device__ bool next(int i, Unit& u) const {
        const long L = (long)i * G + c; if (L >= nwg) return false;
        int wgid = (int)L; { const int q = nwg / NXCD, r = nwg % NXCD, xcd = wgid % NXCD, off = wgid / NXCD; wgid = (xcd < r ? xcd * (q + 1) : r * (q + 1) + (xcd - r) * q) + off; }
        const int nig = WGM * nN, gid = wgid / nig, fm = gid * WGM, gsz = (nM - fm) < WGM ? (nM - fm) : WGM;
        u.pm = fm + ((wgid % nig) % gsz); u.pn = (wgid % nig) / gsz; return true;
    }
    __device__ __forceinline__ void a_ready(const Unit&) const {}
    __device__ __forceinline__ void done(const Unit&) const {}
};

__device__ __forceinline__ unsigned cvt_pk_bf16(float lo, float hi) { unsigned r; asm volatile("v_cvt_pk_bf16_f32 %0, %1, %2" : "=v"(r) : "v"(lo), "v"(hi)); return r; }
typedef unsigned u32x2 __attribute__((ext_vector_type(2)));
typedef float f32x2 __attribute__((ext_vector_type(2)));
__device__ __forceinline__ u32x4 pack8(const f32x4 v0, const f32x4 v1) { u32x4 w; w.x = cvt_pk_bf16(v0[0], v0[1]); w.y = cvt_pk_bf16(v0[2], v0[3]); w.z = cvt_pk_bf16(v1[0], v1[1]); w.w = cvt_pk_bf16(v1[2], v1[3]); return w; }
__device__ __forceinline__ f32x4 shfl32(const f32x4 v) { f32x4 p; p[0] = __shfl_xor(v[0], 32); p[1] = __shfl_xor(v[1], 32); p[2] = __shfl_xor(v[2], 32); p[3] = __shfl_xor(v[3], 32); return p; }
__device__ __forceinline__ f32x4 rope4(const f32x4 v, const float* cosT, const float* sinT, int pos, int fq, int n) {
    const f32x4 p = shfl32(v); const int i0 = (8 * fq + 4 * n) & 15;
    const f32x4 c = *(const f32x4*)(cosT + pos * 16 + i0), s = *(const f32x4*)(sinT + pos * 16 + i0);
    return fq < 2 ? v * c - p * s : v * c + p * s;
}
struct EpiSwiGLU { static constexpr bool PERM = true, AFTER_DRAIN = false, HAS_INIT = false; bf16_t* O; int ldc;
    __device__ __forceinline__ void operator()(const f32x4 (&acc)[2][2][4][2], const Unit& u, int wr, int wc, int fr, int fq) const {
        const int row0 = u.pm * BM + wr * 64 + fr, col0 = u.pn * HALF + wc * 32 + 8 * fq;
#pragma unroll
        for (int ai = 0; ai < 2; ++ai)
#pragma unroll
            for (int m = 0; m < 4; ++m) { bf16_t* rowp = O + (size_t)(row0 + ai * HALF + m * 16) * ldc + col0; f32x4 h[2];
#pragma unroll
                for (int n = 0; n < 2; ++n) { const f32x4 g = acc[ai][0][m][n], up = acc[ai][1][m][n];
#pragma unroll
                    for (int e = 0; e < 4; ++e) h[n][e] = g[e] * __builtin_amdgcn_rcpf(1.0f + __builtin_amdgcn_exp2f(-1.4426950408889634f * g[e])) * up[e]; }
                *(u32x4*)rowp = pack8(h[0], h[1]); }
    }
};
struct EpiResid { static constexpr bool PERM = false, AFTER_DRAIN = false, HAS_INIT = true; const float* base; float* out; const float* st; const float *g, *b; float s;
    __device__ __forceinline__ void init(f32x4 (&acc)[2][2][4][2], const Unit& u, int wr, int wc, int fr, int fq) const {
        const int row0 = u.pm * BM + wr * 64 + fr, col0 = u.pn * BM + wc * 32 + 4 * fq; const float as = 1.681792830507429f / s;
        const unsigned o0 = ((unsigned)row0 * 1024u + (unsigned)col0) * 4u;
        f32x4 gv[2][2], bv[2][2]; float mu8[8], rs8[8];
        if (st) {
#pragma unroll
            for (int it = 0; it < 8; ++it) { const int r = row0 + (it >> 2) * HALF + (it & 3) * 16; const f32x2 ms = *(const f32x2*)((const char*)st + (unsigned)r * 8u); mu8[it] = ms[0]; rs8[it] = ms[1]; }
#pragma unroll
            for (int bj = 0; bj < 2; ++bj)
#pragma unroll
                for (int n = 0; n < 2; ++n) { gv[bj][n] = *(const f32x4*)(g + col0 + bj * HALF + n * 16) * as; bv[bj][n] = *(const f32x4*)(b + col0 + bj * HALF + n * 16) * as; }
        }
#pragma unroll
        for (int ai = 0; ai < 2; ++ai) {
#pragma unroll
            for (int m = 0; m < 4; ++m)
#pragma unroll
                for (int bj = 0; bj < 2; ++bj)
#pragma unroll
                    for (int n = 0; n < 2; ++n) acc[ai][bj][m][n] = *(const f32x4*)((const char*)base + (o0 + (unsigned)((ai * HALF + m * 16) * 4096 + (bj * HALF + n * 16) * 4)));
#pragma unroll
            for (int m = 0; m < 4; ++m)
#pragma unroll
                for (int bj = 0; bj < 2; ++bj)
#pragma unroll
                    for (int n = 0; n < 2; ++n) { if (st) acc[ai][bj][m][n] = (acc[ai][bj][m][n] - mu8[ai * 4 + m]) * rs8[ai * 4 + m] * gv[bj][n] + bv[bj][n]; else acc[ai][bj][m][n] *= as; }
            asm volatile("" ::: "memory");
        }
    }
    __device__ __forceinline__ void operator()(const f32x4 (&acc)[2][2][4][2], const Unit& u, int wr, int wc, int fr, int fq) const {
        const int row0 = u.pm * BM + wr * 64 + fr, col0 = u.pn * BM + wc * 32 + 4 * fq;
#pragma unroll
        for (int ai = 0; ai < 2; ++ai)
#pragma unroll
            for (int m = 0; m < 4; ++m) { const size_t off = (size_t)(row0 + ai * HALF + m * 16) * 1024 + col0;
#pragma unroll
                for (int bj = 0; bj < 2; ++bj)
#pragma unroll
                    for (int n = 0; n < 2; ++n) *(f32x4*)(out + off + bj * HALF + n * 16) = acc[ai][bj][m][n] * s; }
    }
};
struct EpiMixIn { static constexpr bool PERM = true, AFTER_DRAIN = false, HAS_INIT = false;
    bf16_t *sb, *cq, *ckv, *kr; float *ssq_q, *ssq_kv; const float *cosT, *sinT; float qscale;
    __device__ __forceinline__ void operator()(const f32x4 (&acc)[2][2][4][2], const Unit& u, int wr, int wc, int fr, int fq) const {
        const int pn = u.pn, row0 = u.pm * BM + wr * 64 + fr;
        if (pn <= 9) {
            bf16_t* base; int ldc, colt; float sc = 1.f; float* ssq = nullptr;
            if (pn < 6) { base = sb; ldc = 1536; colt = pn * 256; if (pn < 2) sc = qscale; }
            else if (pn < 9) { base = cq; ldc = 768; colt = (pn - 6) * 256; ssq = ssq_q; }
            else { base = ckv; ldc = 256; colt = 0; ssq = ssq_kv; }
            const int col0 = colt + wc * 32 + 8 * fq;
#pragma unroll
            for (int ai = 0; ai < 2; ++ai)
#pragma unroll
                for (int m = 0; m < 4; ++m) { const int r = row0 + ai * HALF + m * 16; bf16_t* rowp = base + (size_t)r * ldc + col0; float ss = 0.f;
#pragma unroll
                    for (int bj = 0; bj < 2; ++bj) { const f32x4 v0 = acc[ai][bj][m][0] * sc, v1 = acc[ai][bj][m][1] * sc;
                        ss += (v0[0] * v0[0] + v0[1] * v0[1]) + (v0[2] * v0[2] + v0[3] * v0[3]) + (v1[0] * v1[0] + v1[1] * v1[1]) + (v1[2] * v1[2] + v1[3] * v1[3]);
                        *(u32x4*)(rowp + bj * HALF) = pack8(v0, v1); }
                    if (ssq) { ss += __shfl_xor(ss, 16); ss += __shfl_xor(ss, 32); if (fq == 0) atomicAdd(ssq + r, ss); } }
        } else if (wc == 0) {
#pragma unroll
            for (int ai = 0; ai < 2; ++ai)
#pragma unroll
                for (int m = 0; m < 4; ++m) { const int r = row0 + ai * HALF + m * 16, pos = r & 8191;
                    const f32x4 v0 = rope4(acc[ai][0][m][0], cosT, sinT, pos, fq, 0), v1 = rope4(acc[ai][0][m][1], cosT, sinT, pos, fq, 1);
                    *(u32x4*)(kr + (size_t)r * 32 + 8 * fq) = pack8(v0, v1); }
        }
    }
};
struct EpiQ { static constexpr bool PERM = true, AFTER_DRAIN = false, HAS_INIT = false; bf16_t* Q; const float* ssq; const float *cosT, *sinT; float c2;
    __device__ __forceinline__ void operator()(const f32x4 (&acc)[2][2][4][2], const Unit& u, int wr, int wc, int fr, int fq) const {
        const int row0 = u.pm * BM + wr * 64 + fr, col0 = u.pn * BM + wc * 32 + 8 * fq;
#pragma unroll
        for (int ai = 0; ai < 2; ++ai)
#pragma unroll
            for (int m = 0; m < 4; ++m) { const int r = row0 + ai * HALF + m * 16, pos = r & 8191; const float rs = c2 / sqrtf(ssq[r] * (1.0f / 768.0f) + 1e-6f);
#pragma unroll
                for (int bj = 0; bj < 2; ++bj) { const int G = 8 * u.pn + 4 * bj + wc; f32x4 v0 = acc[ai][bj][m][0] * rs, v1 = acc[ai][bj][m][1] * rs;
                    if (G % 3 == 2) { v0 = rope4(v0, cosT, sinT, pos, fq, 0); v1 = rope4(v1, cosT, sinT, pos, fq, 1); }
                    *(u32x4*)(Q + (size_t)r * 768 + col0 + bj * HALF) = pack8(v0, v1); } }
    }
};
struct EpiKV { static constexpr bool PERM = true, AFTER_DRAIN = false, HAS_INIT = false; bf16_t* KV; const float* ssq;
    __device__ __forceinline__ void operator()(const f32x4 (&acc)[2][2][4][2], const Unit& u, int wr, int wc, int fr, int fq) const {
        const int row0 = u.pm * BM + wr * 64 + fr, col0 = u.pn * BM + wc * 32 + 8 * fq;
#pragma unroll
        for (int ai = 0; ai < 2; ++ai)
#pragma unroll
            for (int m = 0; m < 4; ++m) { const int r = row0 + ai * HALF + m * 16; const float rs = 1.0f / sqrtf(ssq[r] * (1.0f / 256.0f) + 1e-6f);
#pragma unroll
                for (int bj = 0; bj < 2; ++bj) *(u32x4*)(KV + (size_t)r * 1024 + col0 + bj * HALF) = pack8(acc[ai][bj][m][0] * rs, acc[ai][bj][m][1] * rs); }
    }
};
struct EpiConvIn { static constexpr bool PERM = true, AFTER_DRAIN = false, HAS_INIT = false; bf16_t *U, *GB;
    __device__ __forceinline__ void operator()(const f32x4 (&acc)[2][2][4][2], const Unit& u, int wr, int wc, int fr, int fq) const {
        const int row0 = u.pm * BM + wr * 64 + fr, pn = u.pn;
#pragma unroll
        for (int ai = 0; ai < 2; ++ai)
#pragma unroll
            for (int m = 0; m < 4; ++m) { const size_t r = (size_t)(row0 + ai * HALF + m * 16);
                if (pn < 8) *(u32x4*)(U + r * 1024 + pn * HALF + wc * 32 + 8 * fq) = pack8(acc[ai][0][m][0] * acc[ai][1][m][0], acc[ai][0][m][1] * acc[ai][1][m][1]);
                else {
#pragma unroll
                    for (int bj = 0; bj < 2; ++bj) *(u32x4*)(GB + r * 1024 + (pn - 8) * BM + bj * HALF + wc * 32 + 8 * fq) = pack8(acc[ai][bj][m][0], acc[ai][bj][m][1]); } }
    }
};
template <class Epi, class Sched, bool ALIGN_EPI = false, bool SP2 = false>
__device__ __forceinline__ void gemm_phase(PG8_LAS unsigned char* lds, const Gemm g, const Sched& S, const Epi& E, const int wave_s) {
    const int lane = fresh_lane(), wid = wave_s, tid = wid * 64 + lane, wr = wid >> 2, wc = wid & 3, fr = lane & 15, fq = lane >> 4;
    const int K = g.K, nt = K / BK;
    unsigned voffA[2], voffB[2];
#pragma unroll
    for (int i = 0; i < 2; ++i) { int R, C; stage_rc(tid * 16 + i * 8192, R, C); const int Rb = Epi::PERM ? ((R & ~31) + perm32(R & 31)) : R;
        voffA[i] = (unsigned)(R * K + C) * 2u; voffB[i] = (unsigned)(Rb * K + C) * 2u; }
    const size_t kstep = (size_t)(BK * 2);
    const size_t hstep = (size_t)HALF * K * 2;
    const size_t tstep = 2 * hstep;
    const unsigned ldsw = (unsigned)wid * 1024u;
    const int aoff = lds_byte(wr * 64 + fr, fq * 8), boff = lds_byte(wc * 32 + fr, fq * 8);
#define PG8_SA(b, h) (((b) * 2 + (h)) * HTB)
#define PG8_SB(b, h) ((4 + (b) * 2 + (h)) * HTB)
#define PG8_STAGE(bufoff, gbase, voff) do { _Pragma("unroll") for (int _i = 0; _i < 2; ++_i) \
        __builtin_amdgcn_global_load_lds((const unsigned*)((const char*)(gbase) + (voff)[_i]), (PG8_LAS unsigned*)(lds + (bufoff) + ldsw + _i * 8192), 16, 0, 0); } while (0)
#define PG8_LDA(dst, b, h) do { _Pragma("unroll") for (int m = 0; m < 4; ++m) _Pragma("unroll") for (int k = 0; k < 2; ++k) dst[m][k] = *(const PG8_LAS bf16x8*)(lds + PG8_SA(b, h) + aoff + m * 2048 + k * 1024); } while (0)
#define PG8_LDB(dst, b, h) do { _Pragma("unroll") for (int n = 0; n < 2; ++n) _Pragma("unroll") for (int k = 0; k < 2; ++k) dst[n][k] = *(const PG8_LAS bf16x8*)(lds + PG8_SB(b, h) + boff + n * 2048 + k * 1024); } while (0)
#define PG8_MMA(ai, bj, At, Bt) do { __builtin_amdgcn_s_setprio(1); _Pragma("unroll") for (int m = 0; m < 4; ++m) _Pragma("unroll") for (int n = 0; n < 2; ++n) _Pragma("unroll") for (int k = 0; k < 2; ++k) \
        acc[ai][bj][m][n] = __builtin_amdgcn_mfma_f32_16x16x32_bf16(Bt[n][k], At[m][k], acc[ai][bj][m][n], 0, 0, 0); __builtin_amdgcn_s_setprio(0); } while (0)
#define PG8_WAIT_V(n) asm volatile("s_waitcnt vmcnt(" #n ")" ::: "memory")
#define PG8_WAIT_L(n) asm volatile("s_waitcnt lgkmcnt(" #n ")" ::: "memory")
#define PG8_BAR __builtin_amdgcn_s_barrier()
#define PG8_SCHED __builtin_amdgcn_sched_barrier(0)
    Unit cur, nxt; int ui = 0;
    if (!S.next(0, cur)) return;
    f32x4 acc[2][2][4][2];
    if constexpr (Epi::HAS_INIT) E.init(acc, cur, wr, wc, fr, fq); else {
#pragma unroll
    for (int a = 0; a < 2; ++a)
#pragma unroll
        for (int b = 0; b < 2; ++b)
#pragma unroll
            for (int m = 0; m < 4; ++m)
#pragma unroll
                for (int n = 0; n < 2; ++n) acc[a][b][m][n] = (f32x4){0.f, 0.f, 0.f, 0.f}; }
    bf16x8 At[4][2], B0[2][2], B1[2][2];
    const char* cA = (const char*)g.A + (size_t)cur.pm * tstep; const char* cB = (const char*)g.Bt + (size_t)cur.pn * tstep;
    S.a_ready(cur);
    if constexpr (SP2) {
        PG8_STAGE(PG8_SB(0, 0), cB, voffB); PG8_STAGE(PG8_SB(0, 1), cB + hstep, voffB); PG8_STAGE(PG8_SA(0, 0), cA, voffA); PG8_STAGE(PG8_SA(0, 1), cA + hstep, voffA);
        if (wr == 1) PG8_BAR;
        PG8_WAIT_V(2); PG8_BAR;
        PG8_STAGE(PG8_SB(1, 0), cB + kstep, voffB); PG8_STAGE(PG8_SA(1, 0), cA + kstep, voffA); PG8_STAGE(PG8_SB(1, 1), cB + hstep + kstep, voffB);
        PG8_WAIT_V(6); PG8_BAR;
    } else {
        PG8_STAGE(PG8_SB(0, 0), cB, voffB); PG8_STAGE(PG8_SA(0, 0), cA, voffA); PG8_STAGE(PG8_SB(0, 1), cB + hstep, voffB); PG8_STAGE(PG8_SA(0, 1), cA + hstep, voffA);
        if (wr == 1) PG8_BAR;
        PG8_WAIT_V(4); PG8_BAR;
        PG8_STAGE(PG8_SB(1, 0), cB + kstep, voffB); PG8_STAGE(PG8_SA(1, 0), cA + kstep, voffA); PG8_STAGE(PG8_SB(1, 1), cB + hstep + kstep, voffB);
        PG8_WAIT_V(6); PG8_BAR;
    }
    for (;;) {
        const bool has_next = S.next(ui + 1, nxt);
        const char* nA = has_next ? (const char*)g.A + (size_t)nxt.pm * tstep : cA; const char* nB = has_next ? (const char*)g.Bt + (size_t)nxt.pn * tstep : cB;
        for (int t = 0; t < nt; t += 2) {
            const bool last = (t == nt - 2);
            const char* a1 = cA + (size_t)(t + 1) * kstep;
            const char* a2 = last ? nA : cA + (size_t)(t + 2) * kstep; const char* b2 = last ? nB : cB + (size_t)(t + 2) * kstep;
            const char* a3 = a2 + kstep; const char* b3 = b2 + kstep;
            if (last && has_next) S.a_ready(nxt);
            if constexpr (SP2) {
            PG8_LDB(B0, 0, 0); PG8_LDB(B1, 0, 1); PG8_SCHED; PG8_LDA(At, 0, 0); PG8_STAGE(PG8_SA(1, 1), a1 + hstep, voffA);
            PG8_WAIT_V(8); PG8_WAIT_L(0); PG8_BAR; PG8_MMA(0, 0, At, B0); PG8_MMA(0, 1, At, B1); PG8_BAR; PG8_SCHED;
            PG8_LDA(At, 0, 1); PG8_STAGE(PG8_SB(0, 0), b2, voffB); PG8_STAGE(PG8_SB(0, 1), b2 + hstep, voffB); PG8_STAGE(PG8_SA(0, 0), a2, voffA);
            PG8_WAIT_V(8); PG8_WAIT_L(0); PG8_BAR; PG8_MMA(1, 0, At, B0); PG8_MMA(1, 1, At, B1); PG8_BAR; PG8_SCHED;
            PG8_LDB(B0, 1, 0); PG8_LDB(B1, 1, 1); PG8_SCHED; PG8_LDA(At, 1, 0); PG8_STAGE(PG8_SA(0, 1), a2 + hstep, voffA);
            PG8_WAIT_V(8); PG8_WAIT_L(0); PG8_BAR; PG8_MMA(0, 0, At, B0); PG8_MMA(0, 1, At, B1); PG8_BAR; PG8_SCHED;
            PG8_LDA(At, 1, 1); PG8_STAGE(PG8_SB(1, 0), b3, voffB); PG8_STAGE(PG8_SB(1, 1), b3 + hstep, voffB); PG8_STAGE(PG8_SA(1, 0), a3, voffA);
            PG8_WAIT_V(8); PG8_WAIT_L(0); PG8_BAR; PG8_MMA(1, 0, At, B0); PG8_MMA(1, 1, At, B1); PG8_BAR; PG8_SCHED;
            } else {
            PG8_LDB(B0, 0, 0); PG8_SCHED; PG8_LDA(At, 0, 0); PG8_STAGE(PG8_SA(1, 1), a1 + hstep, voffA);
            PG8_WAIT_L(8); PG8_BAR; PG8_WAIT_L(0); PG8_MMA(0, 0, At, B0); PG8_BAR; PG8_SCHED;
            PG8_LDB(B1, 0, 1); PG8_STAGE(PG8_SB(0, 0), b2, voffB);
            PG8_BAR; PG8_WAIT_L(0); PG8_MMA(0, 1, At, B1); PG8_BAR;
            PG8_LDA(At, 0, 1); PG8_STAGE(PG8_SA(0, 0), a2, voffA);
            PG8_BAR; PG8_WAIT_L(0); PG8_MMA(1, 0, At, B0); PG8_BAR; PG8_SCHED;
            PG8_STAGE(PG8_SB(0, 1), b2 + hstep, voffB);
            PG8_WAIT_V(6); PG8_BAR; PG8_MMA(1, 1, At, B1); PG8_BAR;
            PG8_LDB(B0, 1, 0); PG8_SCHED; PG8_LDA(At, 1, 0); PG8_STAGE(PG8_SA(0, 1), a2 + hstep, voffA);
            PG8_WAIT_L(8); PG8_BAR; PG8_WAIT_L(0); PG8_MMA(0, 0, At, B0); PG8_BAR; PG8_SCHED;
            PG8_LDB(B1, 1, 1); PG8_STAGE(PG8_SB(1, 0), b3, voffB);
            PG8_BAR; PG8_WAIT_L(0); PG8_MMA(0, 1, At, B1); PG8_BAR;
            PG8_LDA(At, 1, 1); PG8_STAGE(PG8_SA(1, 0), a3, voffA);
            PG8_BAR; PG8_WAIT_L(0); PG8_MMA(1, 0, At, B0); PG8_BAR; PG8_SCHED;
            PG8_STAGE(PG8_SB(1, 1), b3 + hstep, voffB);
            PG8_WAIT_V(6); PG8_BAR; PG8_MMA(1, 1, At, B1); PG8_BAR;
            }
        }
        if constexpr (ALIGN_EPI) { if (wr == 0) PG8_BAR; }
        if constexpr (!Epi::AFTER_DRAIN) { E(acc, cur, wr, wc, fr, fq); S.done(cur); }
        if (!has_next) break;
        if constexpr (Epi::HAS_INIT) E.init(acc, nxt, wr, wc, fr, fq); else {
#pragma unroll
        for (int a = 0; a < 2; ++a)
#pragma unroll
            for (int b = 0; b < 2; ++b)
#pragma unroll
                for (int m = 0; m < 4; ++m)
#pragma unroll
                    for (int n = 0; n < 2; ++n) acc[a][b][m][n] = (f32x4){0.f, 0.f, 0.f, 0.f}; }
        cur = nxt; cA = nA; cB = nB; ++ui;
        if constexpr (ALIGN_EPI) { if (wr == 1) PG8_BAR; }
    }
    PG8_WAIT_V(0);
    if constexpr (!ALIGN_EPI) { if (wr == 0) PG8_BAR; }
    PG8_BAR;
    if constexpr (Epi::AFTER_DRAIN) { E.fused(acc, cur, wr, wc, fr, fq, lds, wid, lane); S.done(cur); }
#undef PG8_SA
#undef PG8_SB
#undef PG8_STAGE
#undef PG8_LDA
#undef PG8_LDB
#undef PG8_MMA
#undef PG8_WAIT_V
#undef PG8_WAIT_L
#undef PG8_BAR
#undef PG8_SCHED
}
}
#ifndef PG8_SP2
#define PG8_SP2 true
#endif
#ifndef PG8_ALIGN
#define PG8_ALIGN true
#endif
#define LAS __attribute__((address_space(3)))
typedef unsigned short bf16_t;
typedef short bf16x8 __attribute__((ext_vector_type(8)));
typedef short s16x4 __attribute__((ext_vector_type(4)));
typedef float f32x4 __attribute__((ext_vector_type(4)));
typedef float f32x16 __attribute__((ext_vector_type(16)));
typedef unsigned u32x4 __attribute__((ext_vector_type(4)));
typedef unsigned u32x2 __attribute__((ext_vector_type(2)));
typedef float f32x2_t __attribute__((ext_vector_type(2))); typedef __bf16 bf16x2_t __attribute__((ext_vector_type(2)));
__device__ __forceinline__ unsigned cvtpk(float lo, float hi) { f32x2_t v = {lo, hi}; bf16x2_t b = __builtin_convertvector(v, bf16x2_t); return __builtin_bit_cast(unsigned, b); }
__device__ __forceinline__ s16x4 vtr(const LAS unsigned char* p) { return __builtin_bit_cast(s16x4, __builtin_amdgcn_ds_read_tr16_b64_v4i16((LAS s16x4*)p)); }
__device__ __forceinline__ int crow(int r, int hi) { return (r & 3) + 8 * (r >> 2) + 4 * hi; }
__device__ __forceinline__ bf16x8 packp(const f32x16& p, int b) { u32x4 w; w.x = cvtpk(p[b], p[b + 1]); w.y = cvtpk(p[b + 2], p[b + 3]); w.z = cvtpk(p[b + 4], p[b + 5]); w.w = cvtpk(p[b + 6], p[b + 7]); return __builtin_bit_cast(bf16x8, w); }
__device__ __forceinline__ bf16x8 vfrag(const LAS unsigned char* vp) { const s16x4 lo = vtr(vp), hi = vtr(vp + 512); return (bf16x8){lo[0], lo[1], lo[2], lo[3], hi[0], hi[1], hi[2], hi[3]}; }

constexpr int SEQ = 8192;
constexpr int KP = 208;
constexpr int MLA_KB = 64 * KP, MLA_STAGE = MLA_KB + 8192;

__device__ __forceinline__ void mla_unit(int b, int h, int qb, const bf16_t* Q, const bf16_t* KV, const bf16_t* KR, bf16_t* O, LAS unsigned char* lds, const int wave_s) {
    const int lane = fresh_lane(), wid = wave_s, tid = wid * 64 + lane, r = lane & 31, hi = lane >> 5;
    const size_t rowbase = (size_t)b * SEQ; const int q0 = qb * 256;
    bf16x8 qf[6];
    { const bf16_t* qp = Q + (rowbase + q0 + wid * 32 + r) * 768 + h * 96 + hi * 8;
#pragma unroll
      for (int ks = 0; ks < 6; ++ks) qf[ks] = *(const bf16x8*)(qp + ks * 16); }
    const int NT = 4 * qb + 4;
    const int lrow = tid >> 3, lch = tid & 7;
    const bf16_t* kvsrc = KV + (rowbase + lrow) * 1024 + h * 128 + lch * 8;
    const int kdst = lrow * KP + lch * 16;
    const int vdst = MLA_KB + (lch >> 2) * 4096 + (lrow >> 3) * 512 + (lrow & 7) * 64 + (lch & 3) * 16;
    const int rrow = (tid & 255) >> 2, rch = tid & 3;
    const bf16_t* krsrc = KR + (rowbase + rrow) * 32 + rch * 8;
    const int rdst = rrow * KP + 128 + rch * 16;
    u32x4 kreg, vreg, rreg = {0u, 0u, 0u, 0u};
#define MLA_LOADT(t) do { kreg = *(const u32x4*)(kvsrc + (size_t)(t) * 65536); vreg = *(const u32x4*)(kvsrc + (size_t)(t) * 65536 + 64); if (tid < 256) rreg = *(const u32x4*)(krsrc + (size_t)(t) * 2048); } while (0)
#define MLA_STORET(s) do { *(LAS u32x4*)(lds + (s) * MLA_STAGE + kdst) = kreg; *(LAS u32x4*)(lds + (s) * MLA_STAGE + vdst) = vreg; if (tid < 256) *(LAS u32x4*)(lds + (s) * MLA_STAGE + rdst) = rreg; } while (0)
    MLA_LOADT(0); MLA_STORET(0); __syncthreads();
    float mx = 0.f, l = 0.f; f32x16 o0 = {}, o1 = {}, negm = {};
    const int ka = r * KP + hi * 16;
    const int va = MLA_KB + ((lane >> 4) & 1) * 32 + (lane & 3) * 8 + (4 * hi + ((lane & 15) >> 2)) * 64;
    for (int t = 0; t < NT; ++t) {
        const int st = t & 1; const bool more = (t + 1 < NT);
        if (more) MLA_LOADT(t + 1);
        const int jb = t - (NT - 4);
        const bool active = (jb < 0) || (64 * jb <= wid * 32 + 31);
        if (active) {
            const LAS unsigned char* Ks = lds + st * MLA_STAGE;
            f32x16 p0, p1;
#pragma unroll
            for (int ks = 0; ks < 6; ++ks) {
                const bf16x8 a0 = *(const LAS bf16x8*)(Ks + ka + ks * 32), a1 = *(const LAS bf16x8*)(Ks + ka + 32 * KP + ks * 32);
                p0 = __builtin_amdgcn_mfma_f32_32x32x16_bf16(a0, qf[ks], ks == 0 ? negm : p0, 0, 0, 0);
                p1 = __builtin_amdgcn_mfma_f32_32x32x16_bf16(a1, qf[ks], ks == 0 ? negm : p1, 0, 0, 0);
            }
            if (jb >= 0) { const int qrel = wid * 32 + r, kb = 64 * jb + 4 * hi;
#pragma unroll
                for (int i = 0; i < 16; ++i) { const int kv = kb + (i & 3) + 8 * (i >> 2); if (kv > qrel) p0[i] = -INFINITY; if (kv + 32 > qrel) p1[i] = -INFINITY; } }
            float ra = fmaxf(fmaxf(p0[0], p0[1]), p1[0]), rb = fmaxf(fmaxf(p0[2], p0[3]), p1[1]); ra = fmaxf(fmaxf(ra, p1[2]), p1[3]);
#pragma unroll
            for (int i = 4; i < 16; i += 4) { ra = fmaxf(fmaxf(ra, p0[i]), p0[i + 1]); rb = fmaxf(fmaxf(rb, p0[i + 2]), p0[i + 3]); ra = fmaxf(fmaxf(ra, p1[i]), p1[i + 1]); rb = fmaxf(fmaxf(rb, p1[i + 2]), p1[i + 3]); }
            float rm = fmaxf(ra, rb); rm = fmaxf(rm, __shfl_xor(rm, 32));
            if (t == 0 || __any(rm > 8.0f)) {
                const float d = (t == 0) ? rm : fmaxf(rm, 0.f); mx += d;
#pragma unroll
                for (int i = 0; i < 16; ++i) { p0[i] -= d; p1[i] -= d; negm[i] = -mx; }
                const float alpha = __builtin_amdgcn_exp2f(-d); l *= alpha;
#pragma unroll
                for (int i = 0; i < 16; ++i) { o0[i] *= alpha; o1[i] *= alpha; }
            }
            float sa = 0.f, sb2 = 0.f;
#pragma unroll
            for (int i = 0; i < 16; ++i) { p0[i] = __builtin_amdgcn_exp2f(p0[i]); p1[i] = __builtin_amdgcn_exp2f(p1[i]); sa += p0[i]; sb2 += p1[i]; }
            l += sa + sb2;
            const bf16x8 pw0 = packp(p0, 0), pw1 = packp(p0, 8), pw2 = packp(p1, 0), pw3 = packp(p1, 8);
            const LAS unsigned char* vp = Ks + va;
            o0 = __builtin_amdgcn_mfma_f32_32x32x16_bf16(vfrag(vp), pw0, o0, 0, 0, 0);
            o1 = __builtin_amdgcn_mfma_f32_32x32x16_bf16(vfrag(vp + 4096), pw0, o1, 0, 0, 0);
            o0 = __builtin_amdgcn_mfma_f32_32x32x16_bf16(vfrag(vp + 1024), pw1, o0, 0, 0, 0);
            o1 = __builtin_amdgcn_mfma_f32_32x32x16_bf16(vfrag(vp + 4096 + 1024), pw1, o1, 0, 0, 0);
            o0 = __builtin_amdgcn_mfma_f32_32x32x16_bf16(vfrag(vp + 2048), pw2, o0, 0, 0, 0);
            o1 = __builtin_amdgcn_mfma_f32_32x32x16_bf16(vfrag(vp + 4096 + 2048), pw2, o1, 0, 0, 0);
            o0 = __builtin_amdgcn_mfma_f32_32x32x16_bf16(vfrag(vp + 3072), pw3, o0, 0, 0, 0);
            o1 = __builtin_amdgcn_mfma_f32_32x32x16_bf16(vfrag(vp + 4096 + 3072), pw3, o1, 0, 0, 0);
        }
        if (more) MLA_STORET(st ^ 1);
        __syncthreads();
    }
#undef MLA_LOADT
#undef MLA_STORET
    l += __shfl_xor(l, 32);
    const float inv = 1.0f / l;
    bf16_t* op = O + (rowbase + q0 + wid * 32 + r) * 1024 + 512 + h * 64 + 4 * hi;
#pragma unroll
    for (int g = 0; g < 4; ++g) {
        u32x2 w0, w1; w0.x = cvtpk(o0[4 * g] * inv, o0[4 * g + 1] * inv); w0.y = cvtpk(o0[4 * g + 2] * inv, o0[4 * g + 3] * inv);
        w1.x = cvtpk(o1[4 * g] * inv, o1[4 * g + 1] * inv); w1.y = cvtpk(o1[4 * g + 2] * inv, o1[4 * g + 3] * inv);
        *(u32x2*)(op + 8 * g) = w0; *(u32x2*)(op + 32 + 8 * g) = w1;
    }
}

__device__ __forceinline__ void sb_half(f32x16& p, float& carry, int kvb, int hi, int tq, bool diag) {
    float ln[16];
#pragma unroll
    for (int i = 0; i < 16; ++i) { const float y = p[i]; const float sp = fmaxf(y, 0.f) + __builtin_amdgcn_logf(1.0f + __builtin_amdgcn_exp2f(-fabsf(y)));
        float a = -sp, lb = y - sp;
        if (diag) { const bool valid = (kvb + crow(i, hi)) < tq; a = valid ? a : 0.f; lb = valid ? lb : -INFINITY; }
        ln[i] = a; p[i] = lb; }
    float T[4], PT[4];
#pragma unroll
    for (int g = 0; g < 4; ++g) { T[g] = (ln[4 * g] + ln[4 * g + 1]) + (ln[4 * g + 2] + ln[4 * g + 3]); PT[g] = __shfl_xor(T[g], 32); }
    float own[4], pin[5];
    own[3] = 0.f; own[2] = T[3]; own[1] = own[2] + T[2]; own[0] = own[1] + T[1];
    pin[4] = 0.f; pin[3] = PT[3]; pin[2] = pin[3] + PT[2]; pin[1] = pin[2] + PT[1]; pin[0] = pin[1] + PT[0];
#pragma unroll
    for (int g = 0; g < 4; ++g) { const float S = carry + own[g] + (hi == 0 ? pin[g] : pin[g + 1]);
        const float e3 = S, e2 = e3 + ln[4 * g + 3], e1 = e2 + ln[4 * g + 2], e0 = e1 + ln[4 * g + 1];
        p[4 * g + 3] = __builtin_amdgcn_exp2f(p[4 * g + 3] + e3); p[4 * g + 2] = __builtin_amdgcn_exp2f(p[4 * g + 2] + e2);
        p[4 * g + 1] = __builtin_amdgcn_exp2f(p[4 * g + 1] + e1); p[4 * g] = __builtin_amdgcn_exp2f(p[4 * g] + e0); }
    carry += own[0] + T[0] + pin[0];
}
__device__ __forceinline__ void sb_wave(int b, int h, int t0, const bf16_t* SBq, bf16_t* O, LAS unsigned char* Vs) {
    const int lane = fresh_lane();
    const int r = lane & 31, hi = lane >> 5;
    const size_t rowbase = (size_t)b * SEQ;
    bf16x8 qf[4];
    { const bf16_t* qp = SBq + (rowbase + t0 + r) * 1536 + h * 64 + hi * 8;
#pragma unroll
      for (int ks = 0; ks < 4; ++ks) qf[ks] = *(const bf16x8*)(qp + ks * 16); }
    const bf16_t* Kh = SBq + rowbase * 1536 + 512 + h * 64 + hi * 8;
    const bf16_t* Vh = SBq + rowbase * 1536 + 1024 + h * 64;
    const int va = ((lane >> 4) & 1) * 32 + (lane & 3) * 8 + (4 * hi + ((lane & 15) >> 2)) * 64;
    const int tq = t0 + r, jd = t0 >> 6;
    float R = 0.f; f32x16 o0 = {}, o1 = {};
    for (int j = jd; j >= 0; --j) {
#pragma unroll
        for (int i = 0; i < 8; ++i) { const int row = i * 8 + (lane >> 3), ch = lane & 7;
            const u32x4 v = *(const u32x4*)(Vh + (size_t)(64 * j + row) * 1536 + ch * 8);
            *(LAS u32x4*)(Vs + (ch >> 2) * 4096 + (row >> 3) * 512 + (row & 7) * 64 + (ch & 3) * 16) = v; }
        f32x16 p0 = {}, p1 = {};
#pragma unroll
        for (int ks = 0; ks < 4; ++ks) {
            const bf16x8 a0 = *(const bf16x8*)(Kh + (size_t)(64 * j + r) * 1536 + ks * 16), a1 = *(const bf16x8*)(Kh + (size_t)(64 * j + 32 + r) * 1536 + ks * 16);
            p0 = __builtin_amdgcn_mfma_f32_32x32x16_bf16(a0, qf[ks], p0, 0, 0, 0);
            p1 = __builtin_amdgcn_mfma_f32_32x32x16_bf16(a1, qf[ks], p1, 0, 0, 0);
        }
        const bool diag = (j == jd);
        sb_half(p1, R, 64 * j + 32, hi, tq, diag);
        sb_half(p0, R, 64 * j, hi, tq, diag);
        const bf16x8 pw0 = packp(p0, 0), pw1 = packp(p0, 8), pw2 = packp(p1, 0), pw3 = packp(p1, 8);
        const LAS unsigned char* vp = Vs + va;
        o0 = __builtin_amdgcn_mfma_f32_32x32x16_bf16(vfrag(vp), pw0, o0, 0, 0, 0);
        o1 = __builtin_amdgcn_mfma_f32_32x32x16_bf16(vfrag(vp + 4096), pw0, o1, 0, 0, 0);
        o0 = __builtin_amdgcn_mfma_f32_32x32x16_bf16(vfrag(vp + 1024), pw1, o0, 0, 0, 0);
        o1 = __builtin_amdgcn_mfma_f32_32x32x16_bf16(vfrag(vp + 4096 + 1024), pw1, o1, 0, 0, 0);
        o0 = __builtin_amdgcn_mfma_f32_32x32x16_bf16(vfrag(vp + 2048), pw2, o0, 0, 0, 0);
        o1 = __builtin_amdgcn_mfma_f32_32x32x16_bf16(vfrag(vp + 4096 + 2048), pw2, o1, 0, 0, 0);
        o0 = __builtin_amdgcn_mfma_f32_32x32x16_bf16(vfrag(vp + 3072), pw3, o0, 0, 0, 0);
        o1 = __builtin_amdgcn_mfma_f32_32x32x16_bf16(vfrag(vp + 4096 + 3072), pw3, o1, 0, 0, 0);
        if (__all(R < -32.0f)) break;
    }
    bf16_t* op = O + (rowbase + t0 + r) * 1024 + h * 64 + 4 * hi;
#pragma unroll
    for (int g = 0; g < 4; ++g) {
        u32x2 w0, w1; w0.x = cvtpk(o0[4 * g], o0[4 * g + 1]); w0.y = cvtpk(o0[4 * g + 2], o0[4 * g + 3]);
        w1.x = cvtpk(o1[4 * g], o1[4 * g + 1]); w1.y = cvtpk(o1[4 * g + 2], o1[4 * g + 3]);
        *(u32x2*)(op + 8 * g) = w0; *(u32x2*)(op + 32 + 8 * g) = w1;
    }
}
#define XB_TMO      128
#define XB_XCNT(j)  (256  + 64 * (j))
#define XB_XSUB(j)  (1280 + 64 * (j))
#define XB_XGEN(j)  (2304 + 64 * (j))
#define XB_TOP      3328
#define XB_TOPGEN   3392
#define XCD_BAR_WORDS 3456
#define XB_SPIN_CAP (1u << 18)

__device__ __forceinline__ unsigned xb_ld(unsigned* p)              { return __hip_atomic_load(p, __ATOMIC_RELAXED, __HIP_MEMORY_SCOPE_AGENT); }
__device__ __forceinline__ unsigned xb_add(unsigned* p, unsigned v) { return __hip_atomic_fetch_add(p, v, __ATOMIC_RELAXED, __HIP_MEMORY_SCOPE_AGENT); }
__device__ __forceinline__ unsigned xb_xcc_id() { return (unsigned)__builtin_amdgcn_s_getreg((3 << 11) | 20) & 0xFu; }
#define XB_SPIN(cond, bar) do { unsigned _sp = 0; while (cond) { __builtin_amdgcn_s_sleep(1); \
    if ((++_sp & 255u) == 0u) { if (xb_ld(&(bar)[XB_TMO])) break; if (_sp > XB_SPIN_CAP) { atomicAdd(&(bar)[XB_TMO], 1u); break; } } } } while (0)

struct XcdBarrier {
    unsigned* bar; unsigned x;
    volatile LAS unsigned* st;
};

__device__ __forceinline__ XcdBarrier xcd_barrier_post(unsigned* bar, volatile LAS unsigned* st) {
    XcdBarrier b; b.bar = bar; b.x = xb_xcc_id(); b.st = st;
    if (threadIdx.x == 0) (void)xb_add(&bar[XB_XCNT(b.x)], 1u);
    return b;
}
__device__ __forceinline__ void xcd_barrier_complete(unsigned* bar, unsigned x, unsigned& nloc, unsigned& nx) {
    const unsigned G = gridDim.x * gridDim.y * gridDim.z;
    unsigned sum, cnt, mine, sp = 0u;
    for (;;) {
        sum = 0u; cnt = 0u; mine = 0u;
#pragma unroll
        for (unsigned j = 0; j < 16; ++j) { const unsigned c = xb_ld(&bar[XB_XCNT(j)]); sum += c; cnt += (c > 0u) ? 1u : 0u; mine = (j == x) ? c : mine; }
        if (sum == G) break;
        __builtin_amdgcn_s_sleep(1);
        if ((++sp & 255u) == 0u) { if (xb_ld(&bar[XB_TMO])) break; if (sp > XB_SPIN_CAP) { atomicAdd(&bar[XB_TMO], 1u); break; } }
    }
    nloc = mine > 0u ? mine : 1u; nx = cnt > 0u ? cnt : 1u;
}

__device__ __forceinline__ void xcd_barrier(const XcdBarrier& b) {
    asm volatile("s_waitcnt vmcnt(0)" ::: "memory");
    __syncthreads();
    if (threadIdx.x == 0) {
        unsigned* bar = b.bar;
        __builtin_amdgcn_s_waitcnt(0);
        unsigned nloc = b.st[0], nx = b.st[1];
        if (nloc == 0u) { xcd_barrier_complete(bar, b.x, nloc, nx); b.st[0] = nloc; b.st[1] = nx; }
        const unsigned old = xb_add(&bar[XB_XSUB(b.x)], 1u);
        const unsigned gen = old / nloc;
        if (old + 1u == (gen + 1u) * nloc) {
            __builtin_amdgcn_fence(__ATOMIC_RELEASE, "agent");
            asm volatile("s_waitcnt vmcnt(0)" ::: "memory");
            const unsigned og = xb_add(&bar[XB_TOP], 1u);
            const unsigned tg = og / nx;
            if (og + 1u == (tg + 1u) * nx) xb_add(&bar[XB_TOPGEN], 1u);
            else XB_SPIN(xb_ld(&bar[XB_TOPGEN]) == tg, bar);
            __builtin_amdgcn_fence(__ATOMIC_ACQUIRE, "agent");
            xb_add(&bar[XB_XGEN(b.x)], 1u);
            asm volatile("s_waitcnt vmcnt(0)" ::: "memory");
        } else {
            XB_SPIN(xb_ld(&bar[XB_XGEN(b.x)]) == gen, bar);
            __builtin_amdgcn_fence(__ATOMIC_ACQUIRE, "agent");
            asm volatile("s_waitcnt vmcnt(0)" ::: "memory");
        }
    }
    __syncthreads();
}

constexpr int NWAVES = 8, NTHR = 512;
constexpr int M = 4 * SEQ, D = 1024, DFF = 2816, DEPTH = 4;
constexpr int LDS_BYTES = 147456;
constexpr size_t MiB = 1u << 20;
constexpr size_t WS_BAR = 512 * 1024, WS_BAR_BYTES = 16384; constexpr int MISC_OFF = 131072 + 320;
constexpr size_t WS_STAT = 640 * 1024;
constexpr size_t WS_SSQ = 0, WS_COS = 1 * MiB, WS_SIN = 1 * MiB + 512 * 1024, WS_W = 2 * MiB, WS_XB = 170 * MiB, WS_H = 234 * MiB, WS_Q = 410 * MiB, WS_END = 458 * MiB;
constexpr size_t W_FFN = 8650752, W_FFN_D = 5767168, W_EVEN = 69206016, W_EVEN_SZ = 4784128, W_UQ = 2883584, W_UKV = 3473408, W_MOUT = 3735552, W_ODD = W_EVEN + 2 * W_EVEN_SZ, W_ODD_SZ = 4194304, W_COUT = 3145728;
constexpr float ALPHA = 1.681792830507429f;
constexpr float LOG2E = 1.4426950408889634f;

__device__ __forceinline__ unsigned f2bf(float f) { unsigned u = __builtin_bit_cast(unsigned, f); return (u + 0x7fffu + ((u >> 16) & 1u)) >> 16; }
__device__ __forceinline__ unsigned pk2(float lo, float hi) { return f2bf(lo) | (f2bf(hi) << 16); }
__device__ __forceinline__ float wave_sum(float v) {
#pragma unroll
    for (int o = 1; o < 64; o <<= 1) v += __shfl_xor(v, o);
    return v;
}
__device__ __forceinline__ void transpose_item(const float* W, int K, int N, bf16_t* WT, int k0, int n0, int drow0, const float* gk, LAS float* scr, int lane) {
    const int c4 = (lane & 7) * 4, kr = lane >> 3;
    f32x4 v[8]; float gg[8];
#pragma unroll
    for (int i = 0; i < 8; ++i) { const int kk = i * 8 + kr; v[i] = *(const f32x4*)(W + (size_t)(k0 + kk) * N + n0 + c4); gg[i] = gk ? gk[k0 + kk] : 1.f; }
#pragma unroll
    for (int i = 0; i < 8; ++i) { const int kk = i * 8 + kr; v[i] *= gg[i];
#pragma unroll
        for (int e = 0; e < 4; ++e) scr[kk * 33 + c4 + e] = v[i][e]; }
    asm volatile("s_waitcnt lgkmcnt(0)" ::: "memory");
    const int c = lane & 7;
#pragma unroll
    for (int j = 0; j < 4; ++j) { const int n = (lane >> 3) + 8 * j; const LAS float* sp = scr + (8 * c) * 33 + n;
        u32x4 o; o.x = pk2(sp[0 * 33], sp[1 * 33]); o.y = pk2(sp[2 * 33], sp[3 * 33]); o.z = pk2(sp[4 * 33], sp[5 * 33]); o.w = pk2(sp[6 * 33], sp[7 * 33]);
        *(u32x4*)(WT + (size_t)(drow0 + n) * K + k0 + 8 * c) = o; }
    asm volatile("s_waitcnt lgkmcnt(0)" ::: "memory");
}

struct Args { const float* in[15]; float* out; unsigned char* ws; float inv_freq[16]; int pad[2]; };

__global__ void __launch_bounds__(NTHR, 2) mega_fwd(Args a) {
    extern __shared__ __attribute__((aligned(16))) unsigned char lds_raw[];
    LAS unsigned char* lds = (LAS unsigned char*)lds_raw;
    cg::grid_group grid = cg::this_grid();
    const int wave0 = __builtin_amdgcn_readfirstlane(threadIdx.x >> 6), wave = wave0;
    const int G0 = gridDim.x, bx0 = blockIdx.x, vcu0 = (G0 % 8 == 0) ? (bx0 % 8) * (G0 / 8) + bx0 / 8 : bx0; const int G = G0, bx = bx0, vcu = vcu0;
    const int gw = vcu * NWAVES + wave, NGW = G * NWAVES;
    if (threadIdx.x < 64) ((LAS unsigned*)(lds + 131072))[threadIdx.x * 2] = 0u, ((LAS unsigned*)(lds + 131072))[threadIdx.x * 2 + 1] = 0u;
    __syncthreads();
    XcdBarrier xbar = xcd_barrier_post((unsigned*)(a.ws + WS_BAR), (volatile LAS unsigned*)(lds + MISC_OFF) + 8);
    const float* x_in = a.in[0]; const float* ln_g = a.in[1]; const float* ln_b = a.in[2];
    const float* w_gate = a.in[3]; const float* w_up = a.in[4]; const float* w_down = a.in[5];
    const float* mix_w_in = a.in[6]; const float* q_norm_g = a.in[7]; const float* w_uq = a.in[8]; const float* kv_norm_g = a.in[9]; const float* w_ukv = a.in[10]; const float* mix_w_out = a.in[11];
    const float* conv_w_in = a.in[12]; const float* conv_w = a.in[13]; const float* conv_w_out = a.in[14];
    float* const out0 = a.out; unsigned char* const ws0 = a.ws; float* out = out0; unsigned char* ws = ws0;
    float* ssq_q = (float*)(ws + WS_SSQ); float* ssq_kv = ssq_q + M;
    float* cosT = (float*)(ws + WS_COS); float* sinT = (float*)(ws + WS_SIN);
    bf16_t* Wc = (bf16_t*)(ws + WS_W); bf16_t* XB = (bf16_t*)(ws + WS_XB); bf16_t* H = (bf16_t*)(ws + WS_H); bf16_t* Qb = (bf16_t*)(ws + WS_Q);
    bf16_t* SBb = H; bf16_t* CQ = H + (size_t)M * 1536; bf16_t* CKV = CQ + (size_t)M * 768; bf16_t* KR = CKV + (size_t)M * 256; bf16_t* AO = CQ; bf16_t* KVb = XB;
    bf16_t* Ub = H; bf16_t* GBb = H + (size_t)M * 1024; bf16_t* CA = XB;

    {
        const int lane = fresh_lane(), tid = wave * 64 + lane;
        LAS float* scr = (LAS float*)(lds + wave * 16384);
        constexpr int I_FFN = 1408, I_FFNLF = 3 * I_FFN, I_ALLFFN = 8 * I_FFNLF, I_MIN = 1296, I_UQ = 288, I_UKV = 128, I_MOUT = 512, I_EVEN = I_MIN + I_UQ + I_UKV + I_MOUT, I_CIN = 1536, I_COUT = 512, I_ODD = I_CIN + I_COUT;
        constexpr int NITEMS = I_ALLFFN + 2 * I_EVEN + 2 * I_ODD;
        for (int it = gw; it < NITEMS; it += NGW) {
            if (it < I_ALLFFN) {
                const int lf = it / I_FFNLF, r2 = it % I_FFNLF, which = r2 / I_FFN, item = r2 % I_FFN;
                bf16_t* wb = Wc + (size_t)lf * W_FFN;
                if (which < 2) { const int kb = item / 88, nb = item % 88;
                    transpose_item((which == 0 ? w_gate : w_up) + (size_t)lf * D * DFF, D, DFF, wb, 64 * kb, 32 * nb, 256 * (nb >> 2) + 32 * (nb & 3) + (which ? 128 : 0), nullptr, scr, lane); }
                else { const int kb = item / 32, nb = item % 32;
                    transpose_item(w_down + (size_t)lf * DFF * D, DFF, D, wb + W_FFN_D, 64 * kb, 32 * nb, 32 * nb, nullptr, scr, lane); }
            } else if (it < I_ALLFFN + 2 * I_EVEN) {
                const int r1 = it - I_ALLFFN, j = r1 / I_EVEN; int r2 = r1 % I_EVEN;
                bf16_t* wb = Wc + W_EVEN + (size_t)j * W_EVEN_SZ;
                if (r2 < I_MIN) { const int kb = r2 / 81, nb = r2 % 81; transpose_item(mix_w_in + (size_t)j * D * 2592, D, 2592, wb, 64 * kb, 32 * nb, 32 * nb, nullptr, scr, lane); continue; } r2 -= I_MIN;
                if (r2 < I_UQ) { const int kb = r2 / 24, nb = r2 % 24; transpose_item(w_uq + (size_t)j * 768 * 768, 768, 768, wb + W_UQ, 64 * kb, 32 * nb, 32 * nb, q_norm_g + j * 768, scr, lane); continue; } r2 -= I_UQ;
                if (r2 < I_UKV) { const int kb = r2 / 32, nb = r2 % 32; transpose_item(w_ukv + (size_t)j * 256 * 1024, 256, 1024, wb + W_UKV, 64 * kb, 32 * nb, 32 * nb, kv_norm_g + j * 256, scr, lane); continue; } r2 -= I_UKV;
                { const int kb = r2 / 32, nb = r2 % 32; transpose_item(mix_w_out + (size_t)j * D * D, D, D, wb + W_MOUT, 64 * kb, 32 * nb, 32 * nb, nullptr, scr, lane); }
            } else {
                const int r1 = it - I_ALLFFN - 2 * I_EVEN, j = r1 / I_ODD; int r2 = r1 % I_ODD;
                bf16_t* wb = Wc + W_ODD + (size_t)j * W_ODD_SZ;
                if (r2 < I_CIN) { const int kb = r2 / 96, nb = r2 % 96; int drow;
                    if (nb < 32) drow = 256 * (8 + (nb >> 3)) + 32 * (nb & 7);
                    else { const int c = (nb - 32) & 31; drow = 256 * (c >> 2) + 32 * (c & 3) + (nb >= 64 ? 128 : 0); }
                    transpose_item(conv_w_in + (size_t)j * D * 3072, D, 3072, wb, 64 * kb, 32 * nb, drow, nullptr, scr, lane); }
                else { r2 -= I_CIN; const int kb = r2 / 32, nb = r2 % 32; transpose_item(conv_w_out + (size_t)j * D * D, D, D, wb + W_COUT, 64 * kb, 32 * nb, 32 * nb, nullptr, scr, lane); }
            }
        }
        const int gt = vcu * NTHR + tid, NGT = G * NTHR;
        for (int i = gt; i < SEQ * 16; i += NGT) { const int pos = i >> 4, fi = i & 15; const float ang = (float)pos * a.inv_freq[fi];
            const double rev = (double)ang * 0.15915494309189535; const float fr = (float)(rev - floor(rev));
            cosT[i] = __builtin_amdgcn_cosf(fr); sinT[i] = __builtin_amdgcn_sinf(fr); }
        for (size_t i = gt; i < (size_t)M * D / 8; i += NGT) { const f32x4 v0 = ((const f32x4*)x_in)[2 * i], v1 = ((const f32x4*)x_in)[2 * i + 1];
            u32x4 o; o.x = pk2(v0[0], v0[1]); o.y = pk2(v0[2], v0[3]); o.z = pk2(v1[0], v1[1]); o.w = pk2(v1[2], v1[3]); ((u32x4*)XB)[i] = o; }
    }
    grid.sync();

    for (int l = 0; l < DEPTH; ++l) {
        const int j = l >> 1;
        for (int sub = 0; sub < 3; ++sub) {
            int G = G0, bx = bx0, vcu = vcu0, wave = wave0; unsigned char* ws = ws0; float* out = out0;
            asm volatile("" : "+s"(G), "+s"(bx), "+s"(vcu), "+s"(wave), "+s"(ws), "+s"(out));
            const int gw = vcu * NWAVES + wave, NGW = G * NWAVES;
            float* ssq_q = (float*)(ws + WS_SSQ); float* ssq_kv = ssq_q + M; float* cosT = (float*)(ws + WS_COS); float* sinT = (float*)(ws + WS_SIN);
            bf16_t* Wc = (bf16_t*)(ws + WS_W); bf16_t* XB = (bf16_t*)(ws + WS_XB); bf16_t* H = (bf16_t*)(ws + WS_H); bf16_t* Qb = (bf16_t*)(ws + WS_Q);
            bf16_t* SBb = H; bf16_t* CQ = H + (size_t)M * 1536; bf16_t* CKV = CQ + (size_t)M * 768; bf16_t* KR = CKV + (size_t)M * 256; bf16_t* AO = CQ; bf16_t* KVb = XB;
            bf16_t* Ub = H; bf16_t* GBb = H + (size_t)M * 1024; bf16_t* CA = XB;
            if (sub != 1) {
                const int lf = l * 2 + (sub >> 1);
                const bf16_t* wb = Wc + (size_t)lf * W_FFN;
                { pg8::Gemm g{XB, wb, M, 2 * DFF, D}; pg8::StaticOrder S; S.init(M, 2 * DFF, G, bx); pg8::EpiSwiGLU E{H, DFF};
                  pg8::gemm_phase<pg8::EpiSwiGLU, pg8::StaticOrder, PG8_ALIGN, PG8_SP2>(lds, g, S, E, wave); }
                xcd_barrier(xbar);
                { pg8::Gemm g{H, wb + W_FFN_D, M, D, DFF}; pg8::StaticOrder S; S.init(M, D, G, bx); pg8::EpiResid E{(l == 0 && sub == 0) ? x_in : out, out, (l == 0 && sub == 0) ? nullptr : (const float*)(ws + WS_STAT), ln_g + (size_t)(l * 3 + sub - 1) * D, ln_b + (size_t)(l * 3 + sub - 1) * D, 0.5f};
                  pg8::gemm_phase<pg8::EpiResid, pg8::StaticOrder, PG8_ALIGN, PG8_SP2>(lds, g, S, E, wave); }
                xcd_barrier(xbar);
            } else if ((l & 1) == 0) {
                const bf16_t* wb = Wc + W_EVEN + (size_t)j * W_EVEN_SZ;
                { pg8::Gemm g{XB, wb, M, 2816, D}; pg8::StaticOrder S; S.init(M, 2816, G, bx); pg8::EpiMixIn E{SBb, CQ, CKV, KR, ssq_q, ssq_kv, cosT, sinT, 0.125f * LOG2E};
                  pg8::gemm_phase<pg8::EpiMixIn, pg8::StaticOrder, PG8_ALIGN, PG8_SP2>(lds, g, S, E, wave); }
                xcd_barrier(xbar);
                { pg8::Gemm g{CQ, wb + W_UQ, M, 768, 768}; pg8::StaticOrder S; S.init(M, 768, G, bx); pg8::EpiQ E{Qb, ssq_q, cosT, sinT, 0.10206207261596575f * LOG2E};
                  pg8::gemm_phase<pg8::EpiQ, pg8::StaticOrder, PG8_ALIGN, PG8_SP2>(lds, g, S, E, wave); }
                { pg8::Gemm g{CKV, wb + W_UKV, M, 1024, 256}; pg8::StaticOrder S; S.init(M, 1024, G, G - 1 - bx); pg8::EpiKV E{KVb, ssq_kv};
                  pg8::gemm_phase<pg8::EpiKV, pg8::StaticOrder, PG8_ALIGN, PG8_SP2>(lds, g, S, E, wave); }
                xcd_barrier(xbar);
                for (int i = 0; i * G + vcu < 1024; ++i) { const int L = i * G + vcu, bh = (L & 255) >> 3, s = L & 7, rd = L >> 8, qb = rd == 0 ? s : rd == 1 ? 15 - s : rd == 2 ? 16 + s : 31 - s;
                    sb_wave(bh >> 3, bh & 7, qb * 256 + wave * 32, SBb, AO, lds + wave * 8192); }
                __syncthreads();
                for (int i = 0; i * G + vcu < 1024; ++i) { const int L = i * G + vcu, bh = (L & 255) >> 3, s = L & 7, rd = L >> 8, qb = rd == 0 ? s : rd == 1 ? 15 - s : rd == 2 ? 16 + s : 31 - s;
                    mla_unit(bh >> 3, bh & 7, qb, Qb, KVb, KR, AO, lds, wave); }
                xcd_barrier(xbar);
                { pg8::Gemm g{AO, wb + W_MOUT, M, D, D}; pg8::StaticOrder S; S.init(M, D, G, bx); pg8::EpiResid E{out, out, (const float*)(ws + WS_STAT), ln_g + (size_t)(l * 3 + sub - 1) * D, ln_b + (size_t)(l * 3 + sub - 1) * D, 1.0f};
                  pg8::gemm_phase<pg8::EpiResid, pg8::StaticOrder, PG8_ALIGN, PG8_SP2>(lds, g, S, E, wave); }
                xcd_barrier(xbar);
            } else {
                const bf16_t* wb = Wc + W_ODD + (size_t)j * W_ODD_SZ;
                { pg8::Gemm g{XB, wb, M, 3072, D}; pg8::StaticOrder S; S.init(M, 3072, G, bx); pg8::EpiConvIn E{Ub, GBb};
                  pg8::gemm_phase<pg8::EpiConvIn, pg8::StaticOrder, PG8_ALIGN, PG8_SP2>(lds, g, S, E, wave); }
                xcd_barrier(xbar);
                { const float* cw = conv_w + (size_t)j * 3 * D; const int gt = vcu * NTHR + wave * 64 + fresh_lane(), NGT = G * NTHR;
                  for (int idx = gt; idx < M * 128; idx += NGT) { const int row = idx >> 7, c8 = (idx & 127) * 8, t = row & (SEQ - 1);
                    const u32x4 z4 = {0u, 0u, 0u, 0u};
                    const u32x4 u0 = *(const u32x4*)(Ub + (size_t)row * 1024 + c8), u1 = t >= 1 ? *(const u32x4*)(Ub + (size_t)(row - 1) * 1024 + c8) : z4, u2 = t >= 2 ? *(const u32x4*)(Ub + (size_t)(row - 2) * 1024 + c8) : z4;
                    const u32x4 gb = *(const u32x4*)(GBb + (size_t)row * 1024 + c8);
                    float o[8];
#pragma unroll
                    for (int e = 0; e < 8; ++e) { const int sh = (e & 1) * 16; const unsigned msk = 0xffffu;
                        const float fu0 = __builtin_bit_cast(float, ((u0[e >> 1] >> sh) & msk) << 16), fu1 = __builtin_bit_cast(float, ((u1[e >> 1] >> sh) & msk) << 16), fu2 = __builtin_bit_cast(float, ((u2[e >> 1] >> sh) & msk) << 16), fg = __builtin_bit_cast(float, ((gb[e >> 1] >> sh) & msk) << 16);
                        o[e] = fg * (cw[c8 + e] * fu2 + cw[D + c8 + e] * fu1 + cw[2 * D + c8 + e] * fu0); }
                    u32x4 w; w.x = pk2(o[0], o[1]); w.y = pk2(o[2], o[3]); w.z = pk2(o[4], o[5]); w.w = pk2(o[6], o[7]);
                    *(u32x4*)(CA + (size_t)row * 1024 + c8) = w; } }
                xcd_barrier(xbar);
                { pg8::Gemm g{CA, wb + W_COUT, M, D, D}; pg8::StaticOrder S; S.init(M, D, G, bx); pg8::EpiResid E{out, out, (const float*)(ws + WS_STAT), ln_g + (size_t)(l * 3 + sub - 1) * D, ln_b + (size_t)(l * 3 + sub - 1) * D, 1.0f};
                  pg8::gemm_phase<pg8::EpiResid, pg8::StaticOrder, PG8_ALIGN, PG8_SP2>(lds, g, S, E, wave); }
                xcd_barrier(xbar);
            }
            { const int lane = fresh_lane(); const float* gp = ln_g + (size_t)(l * 3 + sub) * D; const float* bp = ln_b + (size_t)(l * 3 + sub) * D;
              const bool last = (l == DEPTH - 1 && sub == 2); float* stt = (float*)(ws + WS_STAT);
              f32x4 gv[4], bv[4];
#pragma unroll
              for (int q = 0; q < 4; ++q) { gv[q] = ((const f32x4*)gp)[lane + 64 * q]; bv[q] = ((const f32x4*)bp)[lane + 64 * q]; }
              for (int m = gw; m < M; m += NGW) { f32x4* xr = (f32x4*)(out + (size_t)m * D) + lane; f32x4 v[4]; float s = 0.f;
#pragma unroll
                for (int q = 0; q < 4; ++q) { v[q] = xr[64 * q]; s += (v[q][0] + v[q][1]) + (v[q][2] + v[q][3]); }
                const float mean = wave_sum(s) * (1.0f / D); float s2 = 0.f;
#pragma unroll
                for (int q = 0; q < 4; ++q) { v[q] = v[q] - mean; s2 += (v[q][0] * v[q][0] + v[q][1] * v[q][1]) + (v[q][2] * v[q][2] + v[q][3] * v[q][3]); }
                const float rstd = 1.0f / sqrtf(wave_sum(s2) * (1.0f / D) + 1e-5f);
                u32x2* o8 = (u32x2*)(XB + (size_t)m * D) + lane;
#pragma unroll
                for (int q = 0; q < 4; ++q) { const f32x4 y = v[q] * rstd * gv[q] + bv[q]; if (last) xr[64 * q] = y; u32x2 w; w.x = pk2(y[0], y[1]); w.y = pk2(y[2], y[3]); o8[64 * q] = w; }
                if (lane == 0) { ssq_q[m] = 0.f; ssq_kv[m] = 0.f; stt[2 * m] = mean; stt[2 * m + 1] = rstd; } } }
            if (!(l == DEPTH - 1 && sub == 2)) xcd_barrier(xbar);
        }
    }
}

extern "C" void kernel_launch(void* const* d_in, const int* in_sizes, int n_in, void* d_out, int out_size, void* d_ws, size_t ws_size, hipStream_t stream) {
    static int grid = 0;
    if (grid == 0) {
        if (n_in != 15 || out_size != M * D || ws_size < WS_END) { fprintf(stderr, "kernel_launch: unexpected problem (n_in %d out %d ws %zu)\n", n_in, out_size, ws_size); grid = -1; return; }
        int dev = 0, cus = 0, per_cu = 0;
        hipGetDevice(&dev); hipDeviceGetAttribute(&cus, hipDeviceAttributeMultiprocessorCount, dev);
        if (hipFuncSetAttribute((const void*)mega_fwd, hipFuncAttributeMaxDynamicSharedMemorySize, LDS_BYTES) != hipSuccess) { fprintf(stderr, "kernel_launch: hipFuncSetAttribute failed\n"); grid = -1; return; }
        if (hipOccupancyMaxActiveBlocksPerMultiprocessor(&per_cu, (const void*)mega_fwd, NTHR, LDS_BYTES) != hipSuccess || per_cu < 1) { fprintf(stderr, "kernel_launch: occupancy query says %d\n", per_cu); per_cu = 1; }
        (void)hipGetLastError();
        grid = cus * 1;
    }
    if (grid < 0) return;
    Args a{};
    for (int i = 0; i < 15; ++i) a.in[i] = (const float*)d_in[i];
    a.out = (float*)d_out; a.ws = (unsigned char*)d_ws;
    for (int i = 0; i < 16; ++i) a.inv_freq[i] = powf(10000.0f, -(float)i / 16.0f);
    (void)hipMemsetAsync((char*)d_ws + WS_BAR, 0, WS_BAR_BYTES, stream);
    void* args[] = {&a};
    hipError_t e = hipLaunchCooperativeKernel((const void*)mega_fwd, dim3(grid), dim3(NTHR), args, LDS_BYTES, stream);
    if (e != hipSuccess) fprintf(stderr, "cooperative launch failed: %s (grid %d)\n", hipGetErrorString(e), grid);
}
```

```cpp
#include <hip/hip_runtime.h>
#include <hip/hip_cooperative_groups.h>
#include <cstdio>
#include <cstdint>
#include <cmath>
namespace cg = cooperative_groups;

constexpr int SEQ = 8192, M = 4 * SEQ, D = 1024, DFF = 2816, DEPTH = 4;
constexpr size_t MiB = 1u << 20;
constexpr size_t WS_BAR = 512 * 1024, WS_BAR_BYTES = 16384; constexpr int MISC_OFF = 131072 + 320;
constexpr size_t WS_STAT = 640 * 1024;
constexpr size_t WS_SSQ = 0, WS_COS = 1 * MiB, WS_SIN = 1 * MiB + 512 * 1024, WS_W = 2 * MiB, WS_XB = 170 * MiB, WS_H = 234 * MiB, WS_Q = 410 * MiB, WS_END = 458 * MiB;
constexpr size_t WS_SB = WS_H, WS_CQ = WS_H + (size_t)M * 1536 * 2, WS_CKV = WS_CQ + (size_t)M * 768 * 2, WS_KR = WS_CKV + (size_t)M * 256 * 2, WS_AO = WS_CQ, WS_KV = WS_XB, WS_U = WS_H, WS_GB = WS_H + (size_t)M * 1024 * 2, WS_CA = WS_XB;
__device__ __forceinline__ int fresh_lane() { int x; asm volatile("v_mbcnt_lo_u32_b32 %0, -1, 0\n\tv_mbcnt_hi_u32_b32 %0, -1, %0" : "=v"(x)); return x; }
namespace pg8 {
#define PG8_LAS __attribute__((address_space(3)))
typedef unsigned short bf16_t;
typedef short bf16x8 __attribute__((ext_vector_type(8)));
typedef float f32x4 __attribute__((ext_vector_type(4)));
typedef unsigned u32x4 __attribute__((ext_vector_type(4)));
constexpr int BM = 256, BK = 64, HALF = 128, HTB = HALF * BK * 2  , STAGE_BYTES = 8 * HTB, NXCD = 8, WGM = 8;

__host__ __device__ __forceinline__ int lds_byte(int r, int c) { const int st = (r >> 4) * 2 + (c >> 5), rr = r & 15, cc = c & 31, ob = rr * 64 + cc * 2; return st * 1024 + (ob ^ (((ob >> 9) & 1) << 5)); }
__host__ __device__ __forceinline__ void stage_rc(int b, int& R, int& C) { const int st = b / 1024, sb = b % 1024, swz = sb ^ (((sb >> 9) & 1) << 5); R = (st >> 1) * 16 + swz / 64; C = (st & 1) * 32 + (swz % 64) / 2; }
__host__ __device__ __forceinline__ int perm32(int rho) { const int n = rho >> 4, i = rho & 15; return 8 * (i >> 2) + 4 * n + (i & 3); }

struct Unit { int pm, pn; };
struct Gemm { const bf16_t* A; const bf16_t* Bt; int M, N, K; };

struct StaticOrder {
    int nM, nN, nwg, G, c;
    __host__ __device__ void init(int M, int N, int G_, int c_) { nM = M / BM; nN = N / BM; nwg = nM * nN; G = G_; c = c_; }
    __host__ __device__ bool next(int i, Unit& u) const {
        const long L = (long)i * G + c; if (L >= nwg) return false;
        int wgid = (int)L; { const int q = nwg / NXCD, r = nwg % NXCD, xcd = wgid % NXCD, off = wgid / NXCD; wgid = (xcd < r ? xcd * (q + 1) : r * (q + 1) + (xcd - r) * q) + off; }
        const int nig = WGM * nN, gid = wgid / nig, fm = gid * WGM, gsz = (nM - fm) < WGM ? (nM - fm) : WGM;
        u.pm = fm + ((wgid % nig) % gsz); u.pn = (wgid % nig) / gsz; return true;
    }
    __device__ __forceinline__ void a_ready(const Unit&) const {}
    __device__ __forceinline__ void done(const Unit&) const {}
};

__device__ __forceinline__ unsigned cvt_pk_bf16(float lo, float hi) { unsigned r; asm volatile("v_cvt_pk_bf16_f32 %0, %1, %2" : "=v"(r) : "v"(lo), "v"(hi)); return r; }
typedef unsigned u32x2 __attribute__((ext_vector_type(2)));
typedef float f32x2 __attribute__((ext_vector_type(2)));
__device__ __forceinline__ u32x4 pack8(const f32x4 v0, const f32x4 v1) { u32x4 w; w.x = cvt_pk_bf16(v0[0], v0[1]); w.y = cvt_pk_bf16(v0[2], v0[3]); w.z = cvt_pk_bf16(v1[0], v1[1]); w.w = cvt_pk_bf16(v1[2], v1[3]); return w; }
__device__ __forceinline__ f32x4 shfl32(const f32x4 v) { f32x4 p; p[0] = __shfl_xor(v[0], 32); p[1] = __shfl_xor(v[1], 32); p[2] = __shfl_xor(v[2], 32); p[3] = __shfl_xor(v[3], 32); return p; }
__device__ __forceinline__ f32x4 rope4(const f32x4 v, const float* cosT, const float* sinT, int pos, int fq, int n) {
    const f32x4 p = shfl32(v); const int i0 = (8 * fq + 4 * n) & 15;
    const f32x4 c = *(const f32x4*)(cosT + pos * 16 + i0), s = *(const f32x4*)(sinT + pos * 16 + i0);
    return fq < 2 ? v * c - p * s : v * c + p * s;
}
struct EpiSwiGLU { static constexpr bool PERM = true, AFTER_DRAIN = false, HAS_INIT = false; unsigned char* ws;
    __device__ __forceinline__ void operator()(const f32x4 (&acc)[2][2][4][2], const Unit& u, int wr, int wc, int fr, int fq) const {
        bf16_t* O = (bf16_t*)(ws + WS_H); constexpr int ldc = DFF;
        const int row0 = u.pm * BM + wr * 64 + fr, col0 = u.pn * HALF + wc * 32 + 8 * fq;
#pragma unroll
        for (int ai = 0; ai < 2; ++ai)
#pragma unroll
            for (int m = 0; m < 4; ++m) { bf16_t* rowp = O + (size_t)(row0 + ai * HALF + m * 16) * ldc + col0; f32x4 h[2];
#pragma unroll
                for (int n = 0; n < 2; ++n) { const f32x4 g = acc[ai][0][m][n], up = acc[ai][1][m][n];
#pragma unroll
                    for (int e = 0; e < 4; ++e) h[n][e] = g[e] * __builtin_amdgcn_rcpf(1.0f + __builtin_amdgcn_exp2f(-1.4426950408889634f * g[e])) * up[e]; }
                *(u32x4*)rowp = pack8(h[0], h[1]); }
    }
};
struct EpiResid { static constexpr bool PERM = false, AFTER_DRAIN = false, HAS_INIT = true; const float* base; float* out; unsigned char* ws; const float *ln_g, *ln_b; int k; float s;
    __device__ __forceinline__ void init(f32x4 (&acc)[2][2][4][2], const Unit& u, int wr, int wc, int fr, int fq) const {
        const float* st = k > 0 ? (const float*)(ws + WS_STAT) : nullptr; const float* g = ln_g + (size_t)(k > 0 ? k - 1 : 0) * D; const float* b = ln_b + (size_t)(k > 0 ? k - 1 : 0) * D;
        const int row0 = u.pm * BM + wr * 64 + fr, col0 = u.pn * BM + wc * 32 + 4 * fq; const float as = 1.681792830507429f / s;
        const unsigned o0 = ((unsigned)row0 * 1024u + (unsigned)col0) * 4u;
        f32x4 gv[2][2], bv[2][2]; float mu8[8], rs8[8];
        if (st) {
#pragma unroll
            for (int it = 0; it < 8; ++it) { const int r = row0 + (it >> 2) * HALF + (it & 3) * 16; const f32x2 ms = *(const f32x2*)((const char*)st + (unsigned)r * 8u); mu8[it] = ms[0]; rs8[it] = ms[1]; }
#pragma unroll
            for (int bj = 0; bj < 2; ++bj)
#pragma unroll
                for (int n = 0; n < 2; ++n) { gv[bj][n] = *(const f32x4*)(g + col0 + bj * HALF + n * 16) * as; bv[bj][n] = *(const f32x4*)(b + col0 + bj * HALF + n * 16) * as; }
        }
#pragma unroll
        for (int ai = 0; ai < 2; ++ai) {
#pragma unroll
            for (int m = 0; m < 4; ++m)
#pragma unroll
                for (int bj = 0; bj < 2; ++bj)
#pragma unroll
                    for (int n = 0; n < 2; ++n) acc[ai][bj][m][n] = *(const f32x4*)((const char*)base + (o0 + (unsigned)((ai * HALF + m * 16) * 4096 + (bj * HALF + n * 16) * 4)));
#pragma unroll
            for (int m = 0; m < 4; ++m)
#pragma unroll
                for (int bj = 0; bj < 2; ++bj)
#pragma unroll
                    for (int n = 0; n < 2; ++n) { if (st) acc[ai][bj][m][n] = (acc[ai][bj][m][n] - mu8[ai * 4 + m]) * rs8[ai * 4 + m] * gv[bj][n] + bv[bj][n]; else acc[ai][bj][m][n] *= as; }
            asm volatile("" ::: "memory");
        }
    }
    __device__ __forceinline__ void operator()(const f32x4 (&acc)[2][2][4][2], const Unit& u, int wr, int wc, int fr, int fq) const {
        const int row0 = u.pm * BM + wr * 64 + fr, col0 = u.pn * BM + wc * 32 + 4 * fq;
#pragma unroll
        for (int ai = 0; ai < 2; ++ai)
#pragma unroll
            for (int m = 0; m < 4; ++m) { const size_t off = (size_t)(row0 + ai * HALF + m * 16) * 1024 + col0;
#pragma unroll
                for (int bj = 0; bj < 2; ++bj)
#pragma unroll
                    for (int n = 0; n < 2; ++n) *(f32x4*)(out + off + bj * HALF + n * 16) = acc[ai][bj][m][n] * s; }
    }
};
struct EpiMixIn { static constexpr bool PERM = true, AFTER_DRAIN = false, HAS_INIT = false;
    unsigned char* ws;
    __device__ __forceinline__ void operator()(const f32x4 (&acc)[2][2][4][2], const Unit& u, int wr, int wc, int fr, int fq) const {
        bf16_t *sb = (bf16_t*)(ws + WS_SB), *cq = (bf16_t*)(ws + WS_CQ), *ckv = (bf16_t*)(ws + WS_CKV), *kr = (bf16_t*)(ws + WS_KR); float *ssq_q = (float*)(ws + WS_SSQ), *ssq_kv = ssq_q + M;
        const float *cosT = (const float*)(ws + WS_COS), *sinT = (const float*)(ws + WS_SIN); constexpr float qscale = 0.125f * 1.4426950408889634f;
        const int pn = u.pn, row0 = u.pm * BM + wr * 64 + fr;
        if (pn <= 9) {
            bf16_t* base; int ldc, colt; float sc = 1.f; float* ssq = nullptr;
            if (pn < 6) { base = sb; ldc = 1536; colt = pn * 256; if (pn < 2) sc = qscale; }
            else if (pn < 9) { base = cq; ldc = 768; colt = (pn - 6) * 256; ssq = ssq_q; }
            else { base = ckv; ldc = 256; colt = 0; ssq = ssq_kv; }
            const int col0 = colt + wc * 32 + 8 * fq;
#pragma unroll
            for (int ai = 0; ai < 2; ++ai)
#pragma unroll
                for (int m = 0; m < 4; ++m) { const int r = row0 + ai * HALF + m * 16; bf16_t* rowp = base + (size_t)r * ldc + col0; float ss = 0.f;
#pragma unroll
                    for (int bj = 0; bj < 2; ++bj) { const f32x4 v0 = acc[ai][bj][m][0] * sc, v1 = acc[ai][bj][m][1] * sc;
                        ss += (v0[0] * v0[0] + v0[1] * v0[1]) + (v0[2] * v0[2] + v0[3] * v0[3]) + (v1[0] * v1[0] + v1[1] * v1[1]) + (v1[2] * v1[2] + v1[3] * v1[3]);
                        *(u32x4*)(rowp + bj * HALF) = pack8(v0, v1); }
                    if (ssq) { ss += __shfl_xor(ss, 16); ss += __shfl_xor(ss, 32); if (fq == 0) atomicAdd(ssq + r, ss); } }
        } else if (wc == 0) {
#pragma unroll
            for (int ai = 0; ai < 2; ++ai)
#pragma unroll
                for (int m = 0; m < 4; ++m) { const int r = row0 + ai * HALF + m * 16, pos = r & 8191;
                    const f32x4 v0 = rope4(acc[ai][0][m][0], cosT, sinT, pos, fq, 0), v1 = rope4(acc[ai][0][m][1], cosT, sinT, pos, fq, 1);
                    *(u32x4*)(kr + (size_t)r * 32 + 8 * fq) = pack8(v0, v1); }
        }
    }
};
struct EpiQ { static constexpr bool PERM = true, AFTER_DRAIN = false, HAS_INIT = false; unsigned char* ws;
    __device__ __forceinline__ void operator()(const f32x4 (&acc)[2][2][4][2], const Unit& u, int wr, int wc, int fr, int fq) const {
        bf16_t* Q = (bf16_t*)(ws + WS_Q); const float* ssq = (const float*)(ws + WS_SSQ); const float *cosT = (const float*)(ws + WS_COS), *sinT = (const float*)(ws + WS_SIN); constexpr float c2 = 0.10206207261596575f * 1.4426950408889634f;
        const int row0 = u.pm * BM + wr * 64 + fr, col0 = u.pn * BM + wc * 32 + 8 * fq;
#pragma unroll
        for (int ai = 0; ai < 2; ++ai)
#pragma unroll
            for (int m = 0; m < 4; ++m) { const int r = row0 + ai * HALF + m * 16, pos = r & 8191; const float rs = c2 / sqrtf(ssq[r] * (1.0f / 768.0f) + 1e-6f);
#pragma unroll
                for (int bj = 0; bj < 2; ++bj) { const int G = 8 * u.pn + 4 * bj + wc; f32x4 v0 = acc[ai][bj][m][0] * rs, v1 = acc[ai][bj][m][1] * rs;
                    if (G % 3 == 2) { v0 = rope4(v0, cosT, sinT, pos, fq, 0); v1 = rope4(v1, cosT, sinT, pos, fq, 1); }
                    *(u32x4*)(Q + (size_t)r * 768 + col0 + bj * HALF) = pack8(v0, v1); } }
    }
};
struct EpiKV { static constexpr bool PERM = true, AFTER_DRAIN = false, HAS_INIT = false; unsigned char* ws;
    __device__ __forceinline__ void operator()(const f32x4 (&acc)[2][2][4][2], const Unit& u, int wr, int wc, int fr, int fq) const {
        bf16_t* KV = (bf16_t*)(ws + WS_KV); const float* ssq = (const float*)(ws + WS_SSQ) + M;
        const int row0 = u.pm * BM + wr * 64 + fr, col0 = u.pn * BM + wc * 32 + 8 * fq;
#pragma unroll
        for (int ai = 0; ai < 2; ++ai)
#pragma unroll
            for (int m = 0; m < 4; ++m) { const int r = row0 + ai * HALF + m * 16; const float rs = 1.0f / sqrtf(ssq[r] * (1.0f / 256.0f) + 1e-6f);
#pragma unroll
                for (int bj = 0; bj < 2; ++bj) *(u32x4*)(KV + (size_t)r * 1024 + col0 + bj * HALF) = pack8(acc[ai][bj][m][0] * rs, acc[ai][bj][m][1] * rs); }
    }
};
struct EpiConvIn { static constexpr bool PERM = true, AFTER_DRAIN = false, HAS_INIT = false; unsigned char* ws;
    __device__ __forceinline__ void operator()(const f32x4 (&acc)[2][2][4][2], const Unit& u, int wr, int wc, int fr, int fq) const {
        bf16_t *U = (bf16_t*)(ws + WS_U), *GB = (bf16_t*)(ws + WS_GB);
        const int row0 = u.pm * BM + wr * 64 + fr, pn = u.pn;
#pragma unroll
        for (int ai = 0; ai < 2; ++ai)
#pragma unroll
            for (int m = 0; m < 4; ++m) { const size_t r = (size_t)(row0 + ai * HALF + m * 16);
                if (pn < 8) *(u32x4*)(U + r * 1024 + pn * HALF + wc * 32 + 8 * fq) = pack8(acc[ai][0][m][0] * acc[ai][1][m][0], acc[ai][0][m][1] * acc[ai][1][m][1]);
                else {
#pragma unroll
                    for (int bj = 0; bj < 2; ++bj) *(u32x4*)(GB + r * 1024 + (pn - 8) * BM + bj * HALF + wc * 32 + 8 * fq) = pack8(acc[ai][bj][m][0], acc[ai][bj][m][1]); } }
    }
};
template <class Epi, class Sched, bool ALIGN_EPI = false, bool SP2 = false>
__device__ __forceinline__ void gemm_phase(PG8_LAS unsigned char* lds, const Gemm g, const Sched& S, const Epi& E, const int wave_s) {
    const int lane = fresh_lane(), wid = wave_s, tid = wid * 64 + lane, wr = wid >> 2, wc = wid & 3, fr = lane & 15, fq = lane >> 4;
    const int K = g.K, nt = K / BK;
    unsigned voffA[2], voffB[2];
#pragma unroll
    for (int i = 0; i < 2; ++i) { int R, C; stage_rc(tid * 16 + i * 8192, R, C); const int Rb = Epi::PERM ? ((R & ~31) + perm32(R & 31)) : R;
        voffA[i] = (unsigned)(R * K + C) * 2u; voffB[i] = (unsigned)(Rb * K + C) * 2u; }
    const size_t kstep = (size_t)(BK * 2);
    const size_t hstep = (size_t)HALF * K * 2;
    const size_t tstep = 2 * hstep;
    const unsigned ldsw = (unsigned)wid * 1024u;
    const int aoff = lds_byte(wr * 64 + fr, fq * 8), boff = lds_byte(wc * 32 + fr, fq * 8);
#define PG8_SA(b, h) (((b) * 2 + (h)) * HTB)
#define PG8_SB(b, h) ((4 + (b) * 2 + (h)) * HTB)
#define PG8_STAGE(bufoff, gbase, voff) do { _Pragma("unroll") for (int _i = 0; _i < 2; ++_i) \
        __builtin_amdgcn_global_load_lds((const unsigned*)((const char*)(gbase) + (voff)[_i]), (PG8_LAS unsigned*)(lds + (bufoff) + ldsw + _i * 8192), 16, 0, 0); } while (0)
#define PG8_LDA(dst, b, h) do { _Pragma("unroll") for (int m = 0; m < 4; ++m) _Pragma("unroll") for (int k = 0; k < 2; ++k) dst[m][k] = *(const PG8_LAS bf16x8*)(lds + PG8_SA(b, h) + aoff + m * 2048 + k * 1024); } while (0)
#define PG8_LDB(dst, b, h) do { _Pragma("unroll") for (int n = 0; n < 2; ++n) _Pragma("unroll") for (int k = 0; k < 2; ++k) dst[n][k] = *(const PG8_LAS bf16x8*)(lds + PG8_SB(b, h) + boff + n * 2048 + k * 1024); } while (0)
#define PG8_MMA(ai, bj, At, Bt) do { __builtin_amdgcn_s_setprio(1); _Pragma("unroll") for (int m = 0; m < 4; ++m) _Pragma("unroll") for (int n = 0; n < 2; ++n) _Pragma("unroll") for (int k = 0; k < 2; ++k) \
        acc[ai][bj][m][n] = __builtin_amdgcn_mfma_f32_16x16x32_bf16(Bt[n][k], At[m][k], acc[ai][bj][m][n], 0, 0, 0); __builtin_amdgcn_s_setprio(0); } while (0)
#define PG8_WAIT_V(n) asm volatile("s_waitcnt vmcnt(" #n ")" ::: "memory")
#define PG8_WAIT_L(n) asm volatile("s_waitcnt lgkmcnt(" #n ")" ::: "memory")
#define PG8_BAR __builtin_amdgcn_s_barrier()
#define PG8_SCHED __builtin_amdgcn_sched_barrier(0)
    Unit cur, nxt; int ui = 0;
    if (!S.next(0, cur)) return;
    f32x4 acc[2][2][4][2];
    if constexpr (Epi::HAS_INIT) E.init(acc, cur, wr, wc, fr, fq); else {
#pragma unroll
    for (int a = 0; a < 2; ++a)
#pragma unroll
        for (int b = 0; b < 2; ++b)
#pragma unroll
            for (int m = 0; m < 4; ++m)
#pragma unroll
                for (int n = 0; n < 2; ++n) acc[a][b][m][n] = (f32x4){0.f, 0.f, 0.f, 0.f}; }
    bf16x8 At[4][2], B0[2][2], B1[2][2];
    const char* cA = (const char*)g.A + (size_t)cur.pm * tstep; const char* cB = (const char*)g.Bt + (size_t)cur.pn * tstep;
    S.a_ready(cur);
    if constexpr (SP2) {
        PG8_STAGE(PG8_SB(0, 0), cB, voffB); PG8_STAGE(PG8_SB(0, 1), cB + hstep, voffB); PG8_STAGE(PG8_SA(0, 0), cA, voffA); PG8_STAGE(PG8_SA(0, 1), cA + hstep, voffA);
        if (wr == 1) PG8_BAR;
        PG8_WAIT_V(2); PG8_BAR;
        PG8_STAGE(PG8_SB(1, 0), cB + kstep, voffB); PG8_STAGE(PG8_SA(1, 0), cA + kstep, voffA); PG8_STAGE(PG8_SB(1, 1), cB + hstep + kstep, voffB);
        PG8_WAIT_V(6); PG8_BAR;
    } else {
        PG8_STAGE(PG8_SB(0, 0), cB, voffB); PG8_STAGE(PG8_SA(0, 0), cA, voffA); PG8_STAGE(PG8_SB(0, 1), cB + hstep, voffB); PG8_STAGE(PG8_SA(0, 1), cA + hstep, voffA);
        if (wr == 1) PG8_BAR;
        PG8_WAIT_V(4); PG8_BAR;
        PG8_STAGE(PG8_SB(1, 0), cB + kstep, voffB); PG8_STAGE(PG8_SA(1, 0), cA + kstep, voffA); PG8_STAGE(PG8_SB(1, 1), cB + hstep + kstep, voffB);
        PG8_WAIT_V(6); PG8_BAR;
    }
    for (;;) {
        const bool has_next = S.next(ui + 1, nxt);
        const char* nA = has_next ? (const char*)g.A + (size_t)nxt.pm * tstep : cA; const char* nB = has_next ? (const char*)g.Bt + (size_t)nxt.pn * tstep : cB;
        for (int t = 0; t < nt; t += 2) {
            const bool last = (t == nt - 2);
            const char* a1 = cA + (size_t)(t + 1) * kstep;
            const char* a2 = last ? nA : cA + (size_t)(t + 2) * kstep; const char* b2 = last ? nB : cB + (size_t)(t + 2) * kstep;
            const char* a3 = a2 + kstep; const char* b3 = b2 + kstep;
            if (last && has_next) S.a_ready(nxt);
            if constexpr (SP2) {
            PG8_LDB(B0, 0, 0); PG8_LDB(B1, 0, 1); PG8_SCHED; PG8_LDA(At, 0, 0); PG8_STAGE(PG8_SA(1, 1), a1 + hstep, voffA);
            PG8_WAIT_V(8); PG8_WAIT_L(0); PG8_BAR; PG8_MMA(0, 0, At, B0); PG8_MMA(0, 1, At, B1); PG8_BAR; PG8_SCHED;
            PG8_LDA(At, 0, 1); PG8_STAGE(PG8_SB(0, 0), b2, voffB); PG8_STAGE(PG8_SB(0, 1), b2 + hstep, voffB); PG8_STAGE(PG8_SA(0, 0), a2, voffA);
            PG8_WAIT_V(8); PG8_WAIT_L(0); PG8_BAR; PG8_MMA(1, 0, At, B0); PG8_MMA(1, 1, At, B1); PG8_BAR; PG8_SCHED;
            PG8_LDB(B0, 1, 0); PG8_LDB(B1, 1, 1); PG8_SCHED; PG8_LDA(At, 1, 0); PG8_STAGE(PG8_SA(0, 1), a2 + hstep, voffA);
            PG8_WAIT_V(8); PG8_WAIT_L(0); PG8_BAR; PG8_MMA(0, 0, At, B0); PG8_MMA(0, 1, At, B1); PG8_BAR; PG8_SCHED;
            PG8_LDA(At, 1, 1); PG8_STAGE(PG8_SB(1, 0), b3, voffB); PG8_STAGE(PG8_SB(1, 1), b3 + hstep, voffB); PG8_STAGE(PG8_SA(1, 0), a3, voffA);
            PG8_WAIT_V(8); PG8_WAIT_L(0); PG8_BAR; PG8_MMA(1, 0, At, B0); PG8_MMA(1, 1, At, B1); PG8_BAR; PG8_SCHED;
            } else {
            PG8_LDB(B0, 0, 0); PG8_SCHED; PG8_LDA(At, 0, 0); PG8_STAGE(PG8_SA(1, 1), a1 + hstep, voffA);
            PG8_WAIT_L(8); PG8_BAR; PG8_WAIT_L(0); PG8_MMA(0, 0, At, B0); PG8_BAR; PG8_SCHED;
            PG8_LDB(B1, 0, 1); PG8_STAGE(PG8_SB(0, 0), b2, voffB);
            PG8_BAR; PG8_WAIT_L(0); PG8_MMA(0, 1, At, B1); PG8_BAR;
            PG8_LDA(At, 0, 1); PG8_STAGE(PG8_SA(0, 0), a2, voffA);
            PG8_BAR; PG8_WAIT_L(0); PG8_MMA(1, 0, At, B0); PG8_BAR; PG8_SCHED;
            PG8_STAGE(PG8_SB(0, 1), b2 + hstep, voffB);
            PG8_WAIT_V(6); PG8_BAR; PG8_MMA(1, 1, At, B1); PG8_BAR;
            PG8_LDB(B0, 1, 0); PG8_SCHED; PG8_LDA(At, 1, 0); PG8_STAGE(PG8_SA(0, 1), a2 + hstep, voffA);
            PG8_WAIT_L(8); PG8_BAR; PG8_WAIT_L(0); PG8_MMA(0, 0, At, B0); PG8_BAR; PG8_SCHED;
            PG8_LDB(B1, 1, 1); PG8_STAGE(PG8_SB(1, 0), b3, voffB);
            PG8_BAR; PG8_WAIT_L(0); PG8_MMA(0, 1, At, B1); PG8_BAR;
            PG8_LDA(At, 1, 1); PG8_STAGE(PG8_SA(1, 0), a3, voffA);
            PG8_BAR; PG8_WAIT_L(0); PG8_MMA(1, 0, At, B0); PG8_BAR; PG8_SCHED;
            PG8_STAGE(PG8_SB(1, 1), b3 + hstep, voffB);
            PG8_WAIT_V(6); PG8_BAR; PG8_MMA(1, 1, At, B1); PG8_BAR;
            }
        }
        if constexpr (ALIGN_EPI) { if (wr == 0) PG8_BAR; }
        if constexpr (!Epi::AFTER_DRAIN) { E(acc, cur, wr, wc, fr, fq); S.done(cur); }
        if (!has_next) break;
        if constexpr (Epi::HAS_INIT) E.init(acc, nxt, wr, wc, fr, fq); else {
#pragma unroll
        for (int a = 0; a < 2; ++a)
#pragma unroll
            for (int b = 0; b < 2; ++b)
#pragma unroll
                for (int m = 0; m < 4; ++m)
#pragma unroll
                    for (int n = 0; n < 2; ++n) acc[a][b][m][n] = (f32x4){0.f, 0.f, 0.f, 0.f}; }
        cur = nxt; cA = nA; cB = nB; ++ui;
        if constexpr (ALIGN_EPI) { if (wr == 1) PG8_BAR; }
    }
    PG8_WAIT_V(0);
    if constexpr (!ALIGN_EPI) { if (wr == 0) PG8_BAR; }
    PG8_BAR;
    if constexpr (Epi::AFTER_DRAIN) { E.fused(acc, cur, wr, wc, fr, fq, lds, wid, lane); S.done(cur); }
#undef PG8_SA
#undef PG8_SB
#undef PG8_STAGE
#undef PG8_LDA
#undef PG8_LDB
#undef PG8_MMA
#undef PG8_WAIT_V
#undef PG8_WAIT_L
#undef PG8_BAR
#undef PG8_SCHED
}
}
#ifndef PG8_SP2
#define PG8_SP2 true
#endif
#ifndef PG8_ALIGN
#define PG8_ALIGN true
#endif
#define LAS __attribute__((address_space(3)))
typedef unsigned short bf16_t;
typedef short bf16x8 __attribute__((ext_vector_type(8)));
typedef short s16x4 __attribute__((ext_vector_type(4)));
typedef float f32x4 __attribute__((ext_vector_type(4)));
typedef float f32x16 __attribute__((ext_vector_type(16)));
typedef unsigned u32x4 __attribute__((ext_vector_type(4)));
typedef unsigned u32x2 __attribute__((ext_vector_type(2)));
typedef float f32x2_t __attribute__((ext_vector_type(2))); typedef __bf16 bf16x2_t __attribute__((ext_vector_type(2)));
__device__ __forceinline__ unsigned cvtpk(float lo, float hi) { f32x2_t v = {lo, hi}; bf16x2_t b = __builtin_convertvector(v, bf16x2_t); return __builtin_bit_cast(unsigned, b); }
__device__ __forceinline__ s16x4 vtr(const LAS unsigned char* p) { return __builtin_bit_cast(s16x4, __builtin_amdgcn_ds_read_tr16_b64_v4i16((LAS s16x4*)p)); }
__device__ __forceinline__ f32x16 zero16() { float z = 0.f; asm volatile("" : "+v"(z)); f32x16 r;
#pragma unroll
    for (int i = 0; i < 16; ++i) r[i] = z;
    return r; }
__device__ __forceinline__ int crow(int r, int hi) { return (r & 3) + 8 * (r >> 2) + 4 * hi; }
__device__ __forceinline__ bf16x8 packp(const f32x16& p, int b) { u32x4 w; w.x = cvtpk(p[b], p[b + 1]); w.y = cvtpk(p[b + 2], p[b + 3]); w.z = cvtpk(p[b + 4], p[b + 5]); w.w = cvtpk(p[b + 6], p[b + 7]); return __builtin_bit_cast(bf16x8, w); }
__device__ __forceinline__ bf16x8 vfrag(const LAS unsigned char* vp) { const s16x4 lo = vtr(vp), hi = vtr(vp + 512); return (bf16x8){lo[0], lo[1], lo[2], lo[3], hi[0], hi[1], hi[2], hi[3]}; }

constexpr int KP = 208;
constexpr int MLA_KB = 64 * KP, MLA_STAGE = MLA_KB + 8192;

constexpr int MLA_KB2 = 128 * KP, MLA_STAGE2 = MLA_KB2 + 16384;
__device__ __forceinline__ void mla_unit(int b, int h, int qb, const bf16_t* Q, const bf16_t* KV, const bf16_t* KR, bf16_t* O, LAS unsigned char* lds, const int wave_s) {
    const int lane = fresh_lane(), wid = wave_s, tid = wid * 64 + lane, r = lane & 31, hi = lane >> 5;
    const size_t rowbase = (size_t)b * SEQ; const int q0 = qb * 256;
    bf16x8 qf[6];
    { const bf16_t* qp = Q + (rowbase + q0 + wid * 32 + r) * 768 + h * 96 + hi * 8;
#pragma unroll
      for (int ks = 0; ks < 6; ++ks) qf[ks] = *(const bf16x8*)(qp + ks * 16); }
    const int NT = 4 * qb + 4, NT2 = NT >> 1;
    const int lrow = tid >> 3, lch = tid & 7;
    const bf16_t* kvsrc = KV + (rowbase + lrow) * 1024 + h * 128 + lch * 8;
    const int kdst = lrow * KP + lch * 16;
    const int vdst = MLA_KB2 + (lch >> 2) * 4096 + (lrow >> 3) * 512 + (lrow & 7) * 64 + (lch & 3) * 16;
    const int rrow = tid >> 2, rch = tid & 3;
    const bf16_t* krsrc = KR + (rowbase + rrow) * 32 + rch * 8;
    const int rdst = rrow * KP + 128 + rch * 16;
    u32x4 kreg0, kreg1, vreg0, vreg1, rreg;
#define MLA_LOADT(t2) do { const bf16_t* p_ = kvsrc + (size_t)(t2) * 131072; kreg0 = *(const u32x4*)(p_); vreg0 = *(const u32x4*)(p_ + 64); kreg1 = *(const u32x4*)(p_ + 65536); vreg1 = *(const u32x4*)(p_ + 65536 + 64); rreg = *(const u32x4*)(krsrc + (size_t)(t2) * 4096); } while (0)
#define MLA_STORET(s_) do { LAS unsigned char* b_ = lds + (s_) * MLA_STAGE2; *(LAS u32x4*)(b_ + kdst) = kreg0; *(LAS u32x4*)(b_ + kdst + 64 * KP) = kreg1; *(LAS u32x4*)(b_ + vdst) = vreg0; *(LAS u32x4*)(b_ + vdst + 8192) = vreg1; *(LAS u32x4*)(b_ + rdst) = rreg; } while (0)
    MLA_LOADT(0); MLA_STORET(0); __syncthreads();
    float mx = 0.f, l = 0.f; f32x16 o0 = zero16(), o1 = zero16(), negm = zero16();
    const int ka = r * KP + hi * 16;
    const int va = MLA_KB2 + ((lane >> 4) & 1) * 32 + (lane & 3) * 8 + (4 * hi + ((lane & 15) >> 2)) * 64;
    for (int t2 = 0; t2 < NT2; ++t2) {
        const int st = t2 & 1; const bool more = (t2 + 1 < NT2);
        if (more) MLA_LOADT(t2 + 1);
#pragma unroll
        for (int hh = 0; hh < 2; ++hh) {
        const int t = 2 * t2 + hh;
        const int jb = t - (NT - 4);
        const bool active = (jb < 0) || (64 * jb <= wid * 32 + 31);
        if (active) {
            const LAS unsigned char* Ks = lds + st * MLA_STAGE2 + hh * 64 * KP;
            f32x16 p0, p1;
#pragma unroll
            for (int ks = 0; ks < 6; ++ks) {
                const bf16x8 a0 = *(const LAS bf16x8*)(Ks + ka + ks * 32), a1 = *(const LAS bf16x8*)(Ks + ka + 32 * KP + ks * 32);
                p0 = __builtin_amdgcn_mfma_f32_32x32x16_bf16(a0, qf[ks], ks == 0 ? negm : p0, 0, 0, 0);
                p1 = __builtin_amdgcn_mfma_f32_32x32x16_bf16(a1, qf[ks], ks == 0 ? negm : p1, 0, 0, 0);
            }
            if (jb >= 0) { const int qrel = wid * 32 + r, kb = 64 * jb + 4 * hi;
#pragma unroll
                for (int i = 0; i < 16; ++i) { const int kv = kb + (i & 3) + 8 * (i >> 2); if (kv > qrel) p0[i] = -INFINITY; if (kv + 32 > qrel) p1[i] = -INFINITY; } }
            float ra = fmaxf(fmaxf(p0[0], p0[1]), p1[0]), rb = fmaxf(fmaxf(p0[2], p0[3]), p1[1]); ra = fmaxf(fmaxf(ra, p1[2]), p1[3]);
#pragma unroll
            for (int i = 4; i < 16; i += 4) { ra = fmaxf(fmaxf(ra, p0[i]), p0[i + 1]); rb = fmaxf(fmaxf(rb, p0[i + 2]), p0[i + 3]); ra = fmaxf(fmaxf(ra, p1[i]), p1[i + 1]); rb = fmaxf(fmaxf(rb, p1[i + 2]), p1[i + 3]); }
            float rm = fmaxf(ra, rb); rm = fmaxf(rm, __shfl_xor(rm, 32));
            if (t == 0 || __any(rm > 8.0f)) {
                const float d = (t == 0) ? rm : fmaxf(rm, 0.f); mx += d;
#pragma unroll
                for (int i = 0; i < 16; ++i) { p0[i] -= d; p1[i] -= d; negm[i] = -mx; }
                const float alpha = __builtin_amdgcn_exp2f(-d); l *= alpha;
#pragma unroll
                for (int i = 0; i < 16; ++i) { o0[i] *= alpha; o1[i] *= alpha; }
            }
            float sa = 0.f, sb2 = 0.f;
#pragma unroll
            for (int i = 0; i < 16; ++i) { p0[i] = __builtin_amdgcn_exp2f(p0[i]); p1[i] = __builtin_amdgcn_exp2f(p1[i]); sa += p0[i]; sb2 += p1[i]; }
            l += sa + sb2;
            const bf16x8 pw0 = packp(p0, 0), pw1 = packp(p0, 8), pw2 = packp(p1, 0), pw3 = packp(p1, 8);
            const LAS unsigned char* vp = lds + st * MLA_STAGE2 + hh * 8192 + va;
            o0 = __builtin_amdgcn_mfma_f32_32x32x16_bf16(vfrag(vp), pw0, o0, 0, 0, 0);
            o1 = __builtin_amdgcn_mfma_f32_32x32x16_bf16(vfrag(vp + 4096), pw0, o1, 0, 0, 0);
            o0 = __builtin_amdgcn_mfma_f32_32x32x16_bf16(vfrag(vp + 1024), pw1, o0, 0, 0, 0);
            o1 = __builtin_amdgcn_mfma_f32_32x32x16_bf16(vfrag(vp + 4096 + 1024), pw1, o1, 0, 0, 0);
            o0 = __builtin_amdgcn_mfma_f32_32x32x16_bf16(vfrag(vp + 2048), pw2, o0, 0, 0, 0);
            o1 = __builtin_amdgcn_mfma_f32_32x32x16_bf16(vfrag(vp + 4096 + 2048), pw2, o1, 0, 0, 0);
            o0 = __builtin_amdgcn_mfma_f32_32x32x16_bf16(vfrag(vp + 3072), pw3, o0, 0, 0, 0);
            o1 = __builtin_amdgcn_mfma_f32_32x32x16_bf16(vfrag(vp + 4096 + 3072), pw3, o1, 0, 0, 0);
        }
        }
        if (more) MLA_STORET(st ^ 1);
        __syncthreads();
    }
#undef MLA_LOADT
#undef MLA_STORET
    l += __shfl_xor(l, 32);
    const float inv = 1.0f / l;
    bf16_t* op = O + (rowbase + q0 + wid * 32 + r) * 1024 + 512 + h * 64 + 4 * hi;
#pragma unroll
    for (int g = 0; g < 4; ++g) {
        u32x2 w0, w1; w0.x = cvtpk(o0[4 * g] * inv, o0[4 * g + 1] * inv); w0.y = cvtpk(o0[4 * g + 2] * inv, o0[4 * g + 3] * inv);
        w1.x = cvtpk(o1[4 * g] * inv, o1[4 * g + 1] * inv); w1.y = cvtpk(o1[4 * g + 2] * inv, o1[4 * g + 3] * inv);
        *(u32x2*)(op + 8 * g) = w0; *(u32x2*)(op + 32 + 8 * g) = w1;
    }
}

__device__ __forceinline__ void sb_half(f32x16& p, float& carry, int kvb, int hi, int tq, bool diag) {
    float ln[16];
#pragma unroll
    for (int i = 0; i < 16; ++i) { const float y = p[i]; const float sp = fmaxf(y, 0.f) + __builtin_amdgcn_logf(1.0f + __builtin_amdgcn_exp2f(-fabsf(y)));
        float a = -sp, lb = y - sp;
        if (diag) { const bool valid = (kvb + crow(i, hi)) < tq; a = valid ? a : 0.f; lb = valid ? lb : -INFINITY; }
        ln[i] = a; p[i] = lb; }
    float T[4], PT[4];
#pragma unroll
    for (int g = 0; g < 4; ++g) { T[g] = (ln[4 * g] + ln[4 * g + 1]) + (ln[4 * g + 2] + ln[4 * g + 3]); PT[g] = __shfl_xor(T[g], 32); }
    float own[4], pin[5];
    own[3] = 0.f; own[2] = T[3]; own[1] = own[2] + T[2]; own[0] = own[1] + T[1];
    pin[4] = 0.f; pin[3] = PT[3]; pin[2] = pin[3] + PT[2]; pin[1] = pin[2] + PT[1]; pin[0] = pin[1] + PT[0];
#pragma unroll
    for (int g = 0; g < 4; ++g) { const float S = carry + own[g] + (hi == 0 ? pin[g] : pin[g + 1]);
        const float e3 = S, e2 = e3 + ln[4 * g + 3], e1 = e2 + ln[4 * g + 2], e0 = e1 + ln[4 * g + 1];
        p[4 * g + 3] = __builtin_amdgcn_exp2f(p[4 * g + 3] + e3); p[4 * g + 2] = __builtin_amdgcn_exp2f(p[4 * g + 2] + e2);
        p[4 * g + 1] = __builtin_amdgcn_exp2f(p[4 * g + 1] + e1); p[4 * g] = __builtin_amdgcn_exp2f(p[4 * g] + e0); }
    carry += own[0] + T[0] + pin[0];
}
__device__ __forceinline__ void sb_wave(int b, int h, int t0, const bf16_t* SBq, bf16_t* O, LAS unsigned char* Vs) {
    const int lane = fresh_lane();
    const int r = lane & 31, hi = lane >> 5;
    const size_t rowbase = (size_t)b * SEQ;
    bf16x8 qf[4];
    { const bf16_t* qp = SBq + (rowbase + t0 + r) * 1536 + h * 64 + hi * 8;
#pragma unroll
      for (int ks = 0; ks < 4; ++ks) qf[ks] = *(const bf16x8*)(qp + ks * 16); }
    const bf16_t* Kh = SBq + rowbase * 1536 + 512 + h * 64 + hi * 8;
    const bf16_t* Vh = SBq + rowbase * 1536 + 1024 + h * 64;
    const int va = ((lane >> 4) & 1) * 32 + (lane & 3) * 8 + (4 * hi + ((lane & 15) >> 2)) * 64;
    const int tq = t0 + r, jd = t0 >> 6;
    float R = 0.f; f32x16 o0 = zero16(), o1 = zero16();
    for (int j = jd; j >= 0; --j) {
#pragma unroll
        for (int i = 0; i < 8; ++i) { const int row = i * 8 + (lane >> 3), ch = lane & 7;
            const u32x4 v = *(const u32x4*)(Vh + (size_t)(64 * j + row) * 1536 + ch * 8);
            *(LAS u32x4*)(Vs + (ch >> 2) * 4096 + (row >> 3) * 512 + (row & 7) * 64 + (ch & 3) * 16) = v; }
        f32x16 p0 = zero16(), p1 = zero16();
#pragma unroll
        for (int ks = 0; ks < 4; ++ks) {
            const bf16x8 a0 = *(const bf16x8*)(Kh + (size_t)(64 * j + r) * 1536 + ks * 16), a1 = *(const bf16x8*)(Kh + (size_t)(64 * j + 32 + r) * 1536 + ks * 16);
            p0 = __builtin_amdgcn_mfma_f32_32x32x16_bf16(a0, qf[ks], p0, 0, 0, 0);
            p1 = __builtin_amdgcn_mfma_f32_32x32x16_bf16(a1, qf[ks], p1, 0, 0, 0);
        }
        const bool diag = (j == jd);
        sb_half(p1, R, 64 * j + 32, hi, tq, diag);
        sb_half(p0, R, 64 * j, hi, tq, diag);
        const bf16x8 pw0 = packp(p0, 0), pw1 = packp(p0, 8), pw2 = packp(p1, 0), pw3 = packp(p1, 8);
        const LAS unsigned char* vp = Vs + va;
        o0 = __builtin_amdgcn_mfma_f32_32x32x16_bf16(vfrag(vp), pw0, o0, 0, 0, 0);
        o1 = __builtin_amdgcn_mfma_f32_32x32x16_bf16(vfrag(vp + 4096), pw0, o1, 0, 0, 0);
        o0 = __builtin_amdgcn_mfma_f32_32x32x16_bf16(vfrag(vp + 1024), pw1, o0, 0, 0, 0);
        o1 = __builtin_amdgcn_mfma_f32_32x32x16_bf16(vfrag(vp + 4096 + 1024), pw1, o1, 0, 0, 0);
        o0 = __builtin_amdgcn_mfma_f32_32x32x16_bf16(vfrag(vp + 2048), pw2, o0, 0, 0, 0);
        o1 = __builtin_amdgcn_mfma_f32_32x32x16_bf16(vfrag(vp + 4096 + 2048), pw2, o1, 0, 0, 0);
        o0 = __builtin_amdgcn_mfma_f32_32x32x16_bf16(vfrag(vp + 3072), pw3, o0, 0, 0, 0);
        o1 = __builtin_amdgcn_mfma_f32_32x32x16_bf16(vfrag(vp + 4096 + 3072), pw3, o1, 0, 0, 0);
        if (__all(R < -32.0f)) break;
    }
    bf16_t* op = O + (rowbase + t0 + r) * 1024 + h * 64 + 4 * hi;
#pragma unroll
    for (int g = 0; g < 4; ++g) {
        u32x2 w0, w1; w0.x = cvtpk(o0[4 * g], o0[4 * g + 1]); w0.y = cvtpk(o0[4 * g + 2], o0[4 * g + 3]);
        w1.x = cvtpk(o1[4 * g], o1[4 * g + 1]); w1.y = cvtpk(o1[4 * g + 2], o1[4 * g + 3]);
        *(u32x2*)(op + 8 * g) = w0; *(u32x2*)(op + 32 + 8 * g) = w1;
    }
}
#define XB_TMO      128
#define XB_XCNT(j)  (256  + 64 * (j))
#define XB_XSUB(j)  (1280 + 64 * (j))
#define XB_XGEN(j)  (2304 + 64 * (j))
#define XB_TOP      3328
#define XB_TOPGEN   3392
#define XCD_BAR_WORDS 3456
#define XB_SPIN_CAP (1u << 18)

__device__ __forceinline__ unsigned xb_ld(unsigned* p)              { return __hip_atomic_load(p, __ATOMIC_RELAXED, __HIP_MEMORY_SCOPE_AGENT); }
__device__ __forceinline__ unsigned xb_add(unsigned* p, unsigned v) { return __hip_atomic_fetch_add(p, v, __ATOMIC_RELAXED, __HIP_MEMORY_SCOPE_AGENT); }
__device__ __forceinline__ unsigned xb_xcc_id() { return (unsigned)__builtin_amdgcn_s_getreg((3 << 11) | 20) & 0xFu; }
#define XB_SPIN(cond, bar) do { unsigned _sp = 0; while (cond) { __builtin_amdgcn_s_sleep(1); \
    if ((++_sp & 255u) == 0u) { if (xb_ld(&(bar)[XB_TMO])) break; if (_sp > XB_SPIN_CAP) { atomicAdd(&(bar)[XB_TMO], 1u); break; } } } } while (0)

struct XcdBarrier {
    unsigned* bar; unsigned x;
    volatile LAS unsigned* st;
};

__device__ __forceinline__ XcdBarrier xcd_barrier_post(unsigned* bar, volatile LAS unsigned* st) {
    XcdBarrier b; b.bar = bar; b.x = xb_xcc_id(); b.st = st;
    if (threadIdx.x == 0) (void)xb_add(&bar[XB_XCNT(b.x)], 1u);
    return b;
}
__device__ __forceinline__ void xcd_barrier_complete(unsigned* bar, unsigned x, unsigned& nloc, unsigned& nx) {
    const unsigned G = gridDim.x * gridDim.y * gridDim.z;
    unsigned sum, cnt, mine, sp = 0u;
    for (;;) {
        sum = 0u; cnt = 0u; mine = 0u;
#pragma unroll
        for (unsigned j = 0; j < 16; ++j) { const unsigned c = xb_ld(&bar[XB_XCNT(j)]); sum += c; cnt += (c > 0u) ? 1u : 0u; mine = (j == x) ? c : mine; }
        if (sum == G) break;
        __builtin_amdgcn_s_sleep(1);
        if ((++sp & 255u) == 0u) { if (xb_ld(&bar[XB_TMO])) break; if (sp > XB_SPIN_CAP) { atomicAdd(&bar[XB_TMO], 1u); break; } }
    }
    nloc = mine > 0u ? mine : 1u; nx = cnt > 0u ? cnt : 1u;
}

__device__ __forceinline__ void xcd_barrier(const XcdBarrier& b) {
    asm volatile("s_waitcnt vmcnt(0)" ::: "memory");
    __syncthreads();
    if (threadIdx.x == 0) {
        unsigned* bar = b.bar;
        __builtin_amdgcn_s_waitcnt(0);
        unsigned nloc = b.st[0], nx = b.st[1];
        if (nloc == 0u) { xcd_barrier_complete(bar, b.x, nloc, nx); b.st[0] = nloc; b.st[1] = nx; }
        const unsigned old = xb_add(&bar[XB_XSUB(b.x)], 1u);
        const unsigned gen = old / nloc;
        if (old + 1u == (gen + 1u) * nloc) {
            __builtin_amdgcn_fence(__ATOMIC_RELEASE, "agent");
            asm volatile("s_waitcnt vmcnt(0)" ::: "memory");
            const unsigned og = xb_add(&bar[XB_TOP], 1u);
            const unsigned tg = og / nx;
            if (og + 1u == (tg + 1u) * nx) xb_add(&bar[XB_TOPGEN], 1u);
            else XB_SPIN(xb_ld(&bar[XB_TOPGEN]) == tg, bar);
            __builtin_amdgcn_fence(__ATOMIC_ACQUIRE, "agent");
            xb_add(&bar[XB_XGEN(b.x)], 1u);
            asm volatile("s_waitcnt vmcnt(0)" ::: "memory");
        } else {
            XB_SPIN(xb_ld(&bar[XB_XGEN(b.x)]) == gen, bar);
            __builtin_amdgcn_fence(__ATOMIC_ACQUIRE, "agent");
            asm volatile("s_waitcnt vmcnt(0)" ::: "memory");
        }
    }
    __syncthreads();
}

constexpr int NWAVES = 8, NTHR = 512;
constexpr int LDS_BYTES = 147456;
constexpr size_t W_FFN = 8650752, W_FFN_D = 5767168, W_EVEN = 69206016, W_EVEN_SZ = 4784128, W_UQ = 2883584, W_UKV = 3473408, W_MOUT = 3735552, W_ODD = W_EVEN + 2 * W_EVEN_SZ, W_ODD_SZ = 4194304, W_COUT = 3145728;
constexpr float ALPHA = 1.681792830507429f;
constexpr float LOG2E = 1.4426950408889634f;

__device__ __forceinline__ unsigned f2bf(float f) { unsigned u = __builtin_bit_cast(unsigned, f); return (u + 0x7fffu + ((u >> 16) & 1u)) >> 16; }
__device__ __forceinline__ unsigned pk2(float lo, float hi) { return f2bf(lo) | (f2bf(hi) << 16); }
__device__ __forceinline__ float wave_sum(float v) {
#pragma unroll
    for (int o = 1; o < 64; o <<= 1) v += __shfl_xor(v, o);
    return v;
}
__device__ __forceinline__ void transpose_item(const float* W, int K, int N, bf16_t* WT, int k0, int n0, int drow0, const float* gk, LAS float* scr, int lane) {
    const int c4 = (lane & 7) * 4, kr = lane >> 3;
    f32x4 v[8]; float gg[8];
#pragma unroll
    for (int i = 0; i < 8; ++i) { const int kk = i * 8 + kr; v[i] = *(const f32x4*)(W + (size_t)(k0 + kk) * N + n0 + c4); gg[i] = gk ? gk[k0 + kk] : 1.f; }
#pragma unroll
    for (int i = 0; i < 8; ++i) { const int kk = i * 8 + kr; v[i] *= gg[i];
#pragma unroll
        for (int e = 0; e < 4; ++e) scr[kk * 33 + c4 + e] = v[i][e]; }
    asm volatile("s_waitcnt lgkmcnt(0)" ::: "memory");
    const int c = lane & 7;
#pragma unroll
    for (int j = 0; j < 4; ++j) { const int n = (lane >> 3) + 8 * j; const LAS float* sp = scr + (8 * c) * 33 + n;
        u32x4 o; o.x = pk2(sp[0 * 33], sp[1 * 33]); o.y = pk2(sp[2 * 33], sp[3 * 33]); o.z = pk2(sp[4 * 33], sp[5 * 33]); o.w = pk2(sp[6 * 33], sp[7 * 33]);
        *(u32x4*)(WT + (size_t)(drow0 + n) * K + k0 + 8 * c) = o; }
    asm volatile("s_waitcnt lgkmcnt(0)" ::: "memory");
}

struct Args { const float* in[15]; float* out; unsigned char* ws; float inv_freq[16]; int pad[2]; };

__global__ void __launch_bounds__(NTHR, 2) mega_fwd(Args a) {
    extern __shared__ __attribute__((aligned(16))) unsigned char lds_raw[];
    LAS unsigned char* lds = (LAS unsigned char*)lds_raw;
    cg::grid_group grid = cg::this_grid();
    const int wave0 = __builtin_amdgcn_readfirstlane(threadIdx.x >> 6), wave = wave0;
    const int G0 = gridDim.x, bx0 = blockIdx.x, vcu0 = (G0 % 8 == 0) ? (bx0 % 8) * (G0 / 8) + bx0 / 8 : bx0; const int G = G0, bx = bx0, vcu = vcu0;
    const int gw = vcu * NWAVES + wave, NGW = G * NWAVES;
    if (threadIdx.x < 64) ((LAS unsigned*)(lds + 131072))[threadIdx.x * 2] = 0u, ((LAS unsigned*)(lds + 131072))[threadIdx.x * 2 + 1] = 0u;
    __syncthreads();
    XcdBarrier xbar = xcd_barrier_post((unsigned*)(a.ws + WS_BAR), (volatile LAS unsigned*)(lds + MISC_OFF) + 8);
    const float* x_in = a.in[0]; const float* ln_g = a.in[1]; const float* ln_b = a.in[2];
    const float* w_gate = a.in[3]; const float* w_up = a.in[4]; const float* w_down = a.in[5];
    const float* mix_w_in = a.in[6]; const float* q_norm_g = a.in[7]; const float* w_uq = a.in[8]; const float* kv_norm_g = a.in[9]; const float* w_ukv = a.in[10]; const float* mix_w_out = a.in[11];
    const float* conv_w_in = a.in[12]; const float* conv_w = a.in[13]; const float* conv_w_out = a.in[14];
    float* const out0 = a.out; unsigned char* const ws0 = a.ws; float* out = out0; unsigned char* ws = ws0;
    float* ssq_q = (float*)(ws + WS_SSQ); float* ssq_kv = ssq_q + M;
    float* cosT = (float*)(ws + WS_COS); float* sinT = (float*)(ws + WS_SIN);
    bf16_t* Wc = (bf16_t*)(ws + WS_W); bf16_t* XB = (bf16_t*)(ws + WS_XB); bf16_t* H = (bf16_t*)(ws + WS_H); bf16_t* Qb = (bf16_t*)(ws + WS_Q);
    bf16_t* SBb = H; bf16_t* CQ = H + (size_t)M * 1536; bf16_t* CKV = CQ + (size_t)M * 768; bf16_t* KR = CKV + (size_t)M * 256; bf16_t* AO = CQ; bf16_t* KVb = XB;
    bf16_t* Ub = H; bf16_t* GBb = H + (size_t)M * 1024; bf16_t* CA = XB;

    {
        const int lane = fresh_lane(), tid = wave * 64 + lane;
        LAS float* scr = (LAS float*)(lds + wave * 16384);
        constexpr int I_FFN = 1408, I_FFNLF = 3 * I_FFN, I_ALLFFN = 8 * I_FFNLF, I_MIN = 1296, I_UQ = 288, I_UKV = 128, I_MOUT = 512, I_EVEN = I_MIN + I_UQ + I_UKV + I_MOUT, I_CIN = 1536, I_COUT = 512, I_ODD = I_CIN + I_COUT;
        constexpr int NITEMS = I_ALLFFN + 2 * I_EVEN + 2 * I_ODD;
        for (int it = gw; it < NITEMS; it += NGW) {
            if (it < I_ALLFFN) {
                const int lf = it / I_FFNLF, r2 = it % I_FFNLF, which = r2 / I_FFN, item = r2 % I_FFN;
                bf16_t* wb = Wc + (size_t)lf * W_FFN;
                if (which < 2) { const int kb = item / 88, nb = item % 88;
                    transpose_item((which == 0 ? w_gate : w_up) + (size_t)lf * D * DFF, D, DFF, wb, 64 * kb, 32 * nb, 256 * (nb >> 2) + 32 * (nb & 3) + (which ? 128 : 0), nullptr, scr, lane); }
                else { const int kb = item / 32, nb = item % 32;
                    transpose_item(w_down + (size_t)lf * DFF * D, DFF, D, wb + W_FFN_D, 64 * kb, 32 * nb, 32 * nb, nullptr, scr, lane); }
            } else if (it < I_ALLFFN + 2 * I_EVEN) {
                const int r1 = it - I_ALLFFN, j = r1 / I_EVEN; int r2 = r1 % I_EVEN;
                bf16_t* wb = Wc + W_EVEN + (size_t)j * W_EVEN_SZ;
                if (r2 < I_MIN) { const int kb = r2 / 81, nb = r2 % 81; transpose_item(mix_w_in + (size_t)j * D * 2592, D, 2592, wb, 64 * kb, 32 * nb, 32 * nb, nullptr, scr, lane); continue; } r2 -= I_MIN;
                if (r2 < I_UQ) { const int kb = r2 / 24, nb = r2 % 24; transpose_item(w_uq + (size_t)j * 768 * 768, 768, 768, wb + W_UQ, 64 * kb, 32 * nb, 32 * nb, q_norm_g + j * 768, scr, lane); continue; } r2 -= I_UQ;
                if (r2 < I_UKV) { const int kb = r2 / 32, nb = r2 % 32; transpose_item(w_ukv + (size_t)j * 256 * 1024, 256, 1024, wb + W_UKV, 64 * kb, 32 * nb, 32 * nb, kv_norm_g + j * 256, scr, lane); continue; } r2 -= I_UKV;
                { const int kb = r2 / 32, nb = r2 % 32; transpose_item(mix_w_out + (size_t)j * D * D, D, D, wb + W_MOUT, 64 * kb, 32 * nb, 32 * nb, nullptr, scr, lane); }
            } else {
                const int r1 = it - I_ALLFFN - 2 * I_EVEN, j = r1 / I_ODD; int r2 = r1 % I_ODD;
                bf16_t* wb = Wc + W_ODD + (size_t)j * W_ODD_SZ;
                if (r2 < I_CIN) { const int kb = r2 / 96, nb = r2 % 96; int drow;
                    if (nb < 32) drow = 256 * (8 + (nb >> 3)) + 32 * (nb & 7);
                    else { const int c = (nb - 32) & 31; drow = 256 * (c >> 2) + 32 * (c & 3) + (nb >= 64 ? 128 : 0); }
                    transpose_item(conv_w_in + (size_t)j * D * 3072, D, 3072, wb, 64 * kb, 32 * nb, drow, nullptr, scr, lane); }
                else { r2 -= I_CIN; const int kb = r2 / 32, nb = r2 % 32; transpose_item(conv_w_out + (size_t)j * D * D, D, D, wb + W_COUT, 64 * kb, 32 * nb, 32 * nb, nullptr, scr, lane); }
            }
        }
        const int gt = vcu * NTHR + tid, NGT = G * NTHR;
        for (int i = gt; i < SEQ * 16; i += NGT) { const int pos = i >> 4, fi = i & 15; const float ang = (float)pos * a.inv_freq[fi];
            const double rev = (double)ang * 0.15915494309189535; const float fr = (float)(rev - floor(rev));
            cosT[i] = __builtin_amdgcn_cosf(fr); sinT[i] = __builtin_amdgcn_sinf(fr); }
        for (size_t i = gt; i < (size_t)M * D / 8; i += NGT) { const f32x4 v0 = ((const f32x4*)x_in)[2 * i], v1 = ((const f32x4*)x_in)[2 * i + 1];
            u32x4 o; o.x = pk2(v0[0], v0[1]); o.y = pk2(v0[2], v0[3]); o.z = pk2(v1[0], v1[1]); o.w = pk2(v1[2], v1[3]); ((u32x4*)XB)[i] = o; }
    }
    grid.sync();

#define PH int G = G0, bx = bx0, vcu = vcu0, wave = wave0; unsigned char* ws = ws0; float* out = out0; asm volatile("" : "+s"(G), "+s"(bx), "+s"(vcu), "+s"(wave), "+s"(ws), "+s"(out)); (void)G; (void)bx; (void)vcu; (void)wave; (void)ws; (void)out;
#define GEMM_PHASE(EPI, Aoff, Boff, N_, K_, ...) do { pg8::Gemm g{(const bf16_t*)(ws + (Aoff)), (const bf16_t*)(ws + WS_W) + (Boff), M, (N_), (K_)}; pg8::StaticOrder S; S.init(M, (N_), G, bx); pg8::EPI E{__VA_ARGS__}; \
        pg8::gemm_phase<pg8::EPI, pg8::StaticOrder, PG8_ALIGN, PG8_SP2>(lds, g, S, E, wave); } while (0)
    for (int l = 0; l < DEPTH; ++l) {
        for (int sub = 0; sub < 3; ++sub) {
            const int k = l * 3 + sub, j = l >> 1;
            if (sub != 1) {
                const size_t wo = (size_t)(l * 2 + (sub >> 1)) * W_FFN;
                { PH GEMM_PHASE(EpiSwiGLU, WS_XB, wo, 2 * DFF, D, ws); }
                xcd_barrier(xbar);
                { PH GEMM_PHASE(EpiResid, WS_H, wo + W_FFN_D, D, DFF, k == 0 ? x_in : out, out, ws, ln_g, ln_b, k, 0.5f); }
                xcd_barrier(xbar);
            } else if ((l & 1) == 0) {
                const size_t wo = W_EVEN + (size_t)j * W_EVEN_SZ;
                { PH GEMM_PHASE(EpiMixIn, WS_XB, wo, 2816, D, ws); }
                xcd_barrier(xbar);
                { PH GEMM_PHASE(EpiQ, WS_CQ, wo + W_UQ, 768, 768, ws); }
                { PH bx = G - 1 - bx; GEMM_PHASE(EpiKV, WS_CKV, wo + W_UKV, 1024, 256, ws); }
                xcd_barrier(xbar);
                { PH for (int i = 0; i * G + vcu < 1024; ++i) { const int L = i * G + vcu, bh = (L & 255) >> 3, s = L & 7, rd = L >> 8, qb = rd == 0 ? s : rd == 1 ? 15 - s : rd == 2 ? 16 + s : 31 - s;
                    sb_wave(bh >> 3, bh & 7, qb * 256 + wave * 32, (const bf16_t*)(ws + WS_SB), (bf16_t*)(ws + WS_AO), lds + wave * 8192); } }
                __syncthreads();
                { PH for (int i = 0; i * G + vcu < 1024; ++i) { const int L = i * G + vcu, bh = (L & 255) >> 3, s = L & 7, rd = L >> 8, qb = rd == 0 ? s : rd == 1 ? 15 - s : rd == 2 ? 16 + s : 31 - s;
                    mla_unit(bh >> 3, bh & 7, qb, (const bf16_t*)(ws + WS_Q), (const bf16_t*)(ws + WS_KV), (const bf16_t*)(ws + WS_KR), (bf16_t*)(ws + WS_AO), lds, wave); } }
                xcd_barrier(xbar);
                { PH GEMM_PHASE(EpiResid, WS_AO, wo + W_MOUT, D, D, out, out, ws, ln_g, ln_b, k, 1.0f); }
                xcd_barrier(xbar);
            } else {
                const size_t wo = W_ODD + (size_t)j * W_ODD_SZ;
                { PH GEMM_PHASE(EpiConvIn, WS_XB, wo, 3072, D, ws); }
                xcd_barrier(xbar);
                { PH const bf16_t* Ub = (const bf16_t*)(ws + WS_U); const bf16_t* GBb = (const bf16_t*)(ws + WS_GB); bf16_t* CA = (bf16_t*)(ws + WS_CA);
                  const float* cw = conv_w + (size_t)j * 3 * D; const int gt = vcu * NTHR + wave * 64 + fresh_lane(), NGT = G * NTHR;
                  for (int idx = gt; idx < M * 128; idx += NGT) { const int row = idx >> 7, c8 = (idx & 127) * 8, t = row & (SEQ - 1);
                    const u32x4 z4 = {0u, 0u, 0u, 0u};
                    const u32x4 u0 = *(const u32x4*)(Ub + (size_t)row * 1024 + c8), u1 = t >= 1 ? *(const u32x4*)(Ub + (size_t)(row - 1) * 1024 + c8) : z4, u2 = t >= 2 ? *(const u32x4*)(Ub + (size_t)(row - 2) * 1024 + c8) : z4;
                    const u32x4 gb = *(const u32x4*)(GBb + (size_t)row * 1024 + c8);
                    float o[8];
#pragma unroll
                    for (int e = 0; e < 8; ++e) { const int sh = (e & 1) * 16; const unsigned msk = 0xffffu;
                        const float fu0 = __builtin_bit_cast(float, ((u0[e >> 1] >> sh) & msk) << 16), fu1 = __builtin_bit_cast(float, ((u1[e >> 1] >> sh) & msk) << 16), fu2 = __builtin_bit_cast(float, ((u2[e >> 1] >> sh) & msk) << 16), fg = __builtin_bit_cast(float, ((gb[e >> 1] >> sh) & msk) << 16);
                        o[e] = fg * (cw[c8 + e] * fu2 + cw[D + c8 + e] * fu1 + cw[2 * D + c8 + e] * fu0); }
                    u32x4 w; w.x = pk2(o[0], o[1]); w.y = pk2(o[2], o[3]); w.z = pk2(o[4], o[5]); w.w = pk2(o[6], o[7]);
                    *(u32x4*)(CA + (size_t)row * 1024 + c8) = w; } }
                xcd_barrier(xbar);
                { PH GEMM_PHASE(EpiResid, WS_CA, wo + W_COUT, D, D, out, out, ws, ln_g, ln_b, k, 1.0f); }
                xcd_barrier(xbar);
            }
            { PH const int lane = fresh_lane(), gw = vcu * NWAVES + wave, NGW = G * NWAVES; const float* gp = ln_g + (size_t)k * D; const float* bp = ln_b + (size_t)k * D; asm volatile("" : "+s"(gp), "+s"(bp));
              const bool last = (k == 3 * DEPTH - 1); float* stt = (float*)(ws + WS_STAT); float* ssq_q = (float*)(ws + WS_SSQ); float* ssq_kv = ssq_q + M; bf16_t* XB = (bf16_t*)(ws + WS_XB);
              f32x4 gv[4], bv[4];
#pragma unroll
              for (int q = 0; q < 4; ++q) { gv[q] = ((const f32x4*)gp)[lane + 64 * q]; bv[q] = ((const f32x4*)bp)[lane + 64 * q]; }
              f32x4 nv[4];
              { const int m0 = gw < M ? gw : 0;
#pragma unroll
                  for (int q = 0; q < 4; ++q) nv[q] = ((const f32x4*)(out + (size_t)m0 * D) + lane)[64 * q]; }
              for (int m = gw; m < M; m += NGW) { f32x4* xr = (f32x4*)(out + (size_t)m * D) + lane; f32x4 v[4]; float s = 0.f;
#pragma unroll
                for (int q = 0; q < 4; ++q) { v[q] = nv[q]; s += (v[q][0] + v[q][1]) + (v[q][2] + v[q][3]); }
                if (m + NGW < M) {
#pragma unroll
                    for (int q = 0; q < 4; ++q) nv[q] = ((const f32x4*)(out + (size_t)(m + NGW) * D) + lane)[64 * q]; }
                const float mean = wave_sum(s) * (1.0f / D); float s2 = 0.f;
#pragma unroll
                for (int q = 0; q < 4; ++q) { v[q] = v[q] - mean; s2 += (v[q][0] * v[q][0] + v[q][1] * v[q][1]) + (v[q][2] * v[q][2] + v[q][3] * v[q][3]); }
                const float rstd = 1.0f / sqrtf(wave_sum(s2) * (1.0f / D) + 1e-5f);
                u32x2* o8 = (u32x2*)(XB + (size_t)m * D) + lane;
#pragma unroll
                for (int q = 0; q < 4; ++q) { const f32x4 y = v[q] * rstd * gv[q] + bv[q]; if (last) xr[64 * q] = y; u32x2 w; w.x = pk2(y[0], y[1]); w.y = pk2(y[2], y[3]); o8[64 * q] = w; }
                if (lane == 0) { ssq_q[m] = 0.f; ssq_kv[m] = 0.f; stt[2 * m] = mean; stt[2 * m + 1] = rstd; } } }
            if (k != 3 * DEPTH - 1) xcd_barrier(xbar);
        }
    }
#undef PH
#undef GEMM_PHASE
}

extern "C" void kernel_launch(void* const* d_in, const int* in_sizes, int n_in, void* d_out, int out_size, void* d_ws, size_t ws_size, hipStream_t stream) {
    static int grid = 0;
    if (grid == 0) {
        if (n_in != 15 || out_size != M * D || ws_size < WS_END) { fprintf(stderr, "kernel_launch: unexpected problem (n_in %d out %d ws %zu)\n", n_in, out_size, ws_size); grid = -1; return; }
        int dev = 0, cus = 0, per_cu = 0;
        hipGetDevice(&dev); hipDeviceGetAttribute(&cus, hipDeviceAttributeMultiprocessorCount, dev);
        if (hipFuncSetAttribute((const void*)mega_fwd, hipFuncAttributeMaxDynamicSharedMemorySize, LDS_BYTES) != hipSuccess) { fprintf(stderr, "kernel_launch: hipFuncSetAttribute failed\n"); grid = -1; return; }
        if (hipOccupancyMaxActiveBlocksPerMultiprocessor(&per_cu, (const void*)mega_fwd, NTHR, LDS_BYTES) != hipSuccess || per_cu < 1) { fprintf(stderr, "kernel_launch: occupancy query says %d\n", per_cu); per_cu = 1; }
        (void)hipGetLastError();
        grid = cus * 1;
    }
    if (grid < 0) return;
    Args a{};
    for (int i = 0; i < 15; ++i) a.in[i] = (const float*)d_in[i];
    a.out = (float*)d_out; a.ws = (unsigned char*)d_ws;
    for (int i = 0; i < 16; ++i) a.inv_freq[i] = powf(10000.0f, -(float)i / 16.0f);
    (void)hipMemsetAsync((char*)d_ws + WS_BAR, 0, WS_BAR_BYTES, stream);
    void* args[] = {&a};
    hipError_t e = hipLaunchCooperativeKernel((const void*)mega_fwd, dim3(grid), dim3(NTHR), args, LDS_BYTES, stream);
    if (e != hipSuccess) fprintf(stderr, "cooperative launch failed: %s (grid %d)\n", hipGetErrorString(e), grid);
}
```
